# Optimizing an MI355X kernel written in HIP

```python
import jax, jax.numpy as jnp
from jax import lax
import numpy as np

D_MODEL = 2048
BATCH = 4
SEQ = 4096
DEPTH = 1

RW_HEADS = 16
RW_HEAD_DIM = 64
RW_WIDTH = RW_HEADS * RW_HEAD_DIM
DECAY_LORA = 64
ICLR_LORA = 64
LNX_EPS = 64e-5
AT_HEADS = 16
AT_KV_HEADS = 4
AT_HEAD_DIM = 64
AT_GROUP = AT_HEADS // AT_KV_HEADS
AT_WIDTH = AT_HEADS * AT_HEAD_DIM
AT_KV_WIDTH = AT_KV_HEADS * AT_HEAD_DIM
WINDOW = 128
BLOCK = 128
NEG_INF = -1e30
N_BRANCH = 2
NORM_EPS = 1e-6
RW_COLS = 4 * RW_WIDTH + DECAY_LORA + ICLR_LORA
AT_COLS = 2 * AT_WIDTH + 2 * AT_KV_WIDTH
GATE_COLS = N_BRANCH * D_MODEL
IN_COLS = RW_COLS + AT_COLS + GATE_COLS

kernel_name = "hybrid_rwkv7_swa_sink_gated_merge"


def rms_norm(x, g, eps=NORM_EPS):
    xf = x.astype(jnp.float32)
    return xf * lax.rsqrt(jnp.mean(xf * xf, axis=-1, keepdims=True) + eps) * g.astype(jnp.float32)


def rwkv7_scan(r, w, k, v, a, b):
    Bsz, T, H, N = r.shape

    def step(S, inp):
        r_t, w_t, k_t, v_t, a_t, b_t = inp
        sa = jnp.einsum('bhij,bhj->bhi', S, a_t)
        S = S * w_t[:, :, None, :] + sa[..., None] * b_t[:, :, None, :] + v_t[..., None] * k_t[:, :, None, :]
        return S, jnp.einsum('bhij,bhj->bhi', S, r_t)

    xs = tuple(jnp.moveaxis(t.astype(jnp.float32), 1, 0) for t in (r, w, k, v, a, b))
    S0 = jnp.zeros((Bsz, H, N, N), jnp.float32)
    _, y = lax.scan(step, S0, xs)
    return jnp.moveaxis(y, 0, 1)


def rwkv7_branch(p, mu, w0, w2, a0, a2, k_k, k_a, r_k, lnx_w, lnx_b):
    Bsz, T, _ = p.shape
    H, N = RW_HEADS, RW_HEAD_DIM
    p = p.astype(jnp.float32)
    p_prev = jnp.pad(p, ((0, 0), (1, 0), (0, 0)))[:, :-1]
    p = p + (p_prev - p) * mu
    r, k, v, gate, wd, ad = jnp.split(
        p, [RW_WIDTH, 2 * RW_WIDTH, 3 * RW_WIDTH, 4 * RW_WIDTH, 4 * RW_WIDTH + DECAY_LORA], axis=-1)
    logw = -jax.nn.softplus(-(w0 + jnp.tanh(wd) @ w2)) - 0.5
    decay = jnp.exp(-jnp.exp(logw))
    a = jax.nn.sigmoid(a0 + ad @ a2)
    kk = (k * k_k).reshape(Bsz, T, H, N)
    kk = kk / jnp.maximum(jnp.sqrt(jnp.sum(kk * kk, axis=-1, keepdims=True)), 1e-12)
    k = k * (1.0 + (a - 1.0) * k_a)
    hs = lambda t: t.reshape(Bsz, T, H, N)
    r_h, k_h, v_h, a_h = hs(r), hs(k), hs(v), hs(a)
    y = rwkv7_scan(r_h, hs(decay), k_h, v_h, -kk, kk * a_h)
    mean = jnp.mean(y, axis=-1, keepdims=True)
    var = jnp.mean(jnp.square(y - mean), axis=-1, keepdims=True)
    y = ((y - mean) * lax.rsqrt(var + LNX_EPS)).reshape(Bsz, T, RW_WIDTH) * lnx_w + lnx_b
    bonus = jnp.sum(r_h * k_h * r_k, axis=-1, keepdims=True) * v_h
    y = y + bonus.reshape(Bsz, T, RW_WIDTH)
    return y * jax.nn.silu(gate)


def swa_sink_branch(p, q_norm, k_norm, sinks):
    Bsz, T, _ = p.shape
    q, gate, k, v = jnp.split(p, [AT_WIDTH, 2 * AT_WIDTH, 2 * AT_WIDTH + AT_KV_WIDTH], axis=-1)
    q = rms_norm(q.reshape(Bsz, T, AT_HEADS, AT_HEAD_DIM), q_norm)
    k = rms_norm(k.reshape(Bsz, T, AT_KV_HEADS, AT_HEAD_DIM), k_norm)
    v = v.reshape(Bsz, T, AT_KV_HEADS, AT_HEAD_DIM).astype(jnp.float32)
    nb = T // BLOCK
    qb = q.reshape(Bsz, nb, BLOCK, AT_KV_HEADS, AT_GROUP, AT_HEAD_DIM)

    def band(t):
        tb = t.reshape(Bsz, nb, BLOCK, AT_KV_HEADS, AT_HEAD_DIM)
        prev = jnp.pad(tb, ((0, 0), (1, 0), (0, 0), (0, 0), (0, 0)))[:, :-1]
        return jnp.concatenate([prev, tb], axis=2)

    kb, vb = band(k), band(v)
    s = jnp.einsum('bnqkgd,bnskd->bnkgqs', qb, kb) * (AT_HEAD_DIM ** -0.5)
    qi = jnp.arange(BLOCK)[:, None]
    si = jnp.arange(2 * BLOCK)[None, :]
    blk = jnp.arange(nb)[:, None, None]
    diff = qi + BLOCK - si
    allowed = (diff >= 0) & (diff < WINDOW) & (blk * BLOCK + si - BLOCK >= 0)
    s = jnp.where(allowed[None, :, None, None, :, :], s, NEG_INF)
    sink = jnp.broadcast_to(
        sinks.astype(jnp.float32).reshape(AT_KV_HEADS, AT_GROUP)[None, None, :, :, None, None],
        s.shape[:-1] + (1,))
    prob = jax.nn.softmax(jnp.concatenate([s, sink], axis=-1), axis=-1)[..., :-1]
    o = jnp.einsum('bnkgqs,bnskd->bnqkgd', prob, vb).reshape(Bsz, T, AT_WIDTH)
    return o * jax.nn.silu(gate.astype(jnp.float32))


def setup_inputs(seed: int = 0) -> dict:
    key = jax.random.key(seed)
    ks = jax.random.split(key, 24)
    L, D = DEPTH, D_MODEL
    nrm = lambda k, shape, s: jax.random.normal(k, shape, jnp.float32) * s
    return {
        "x": nrm(ks[0], (BATCH, SEQ, D), 1.0),
        "c": nrm(ks[1], (BATCH, D), 1.0),
        "ada_w": nrm(ks[2], (L, D, 3 * D), 0.5 * D ** -0.5),
        "ada_b": nrm(ks[3], (L, 3 * D), 0.01),
        "norm_g": 1.0 + nrm(ks[4], (L, D), 0.1),
        "w_in": nrm(ks[5], (L, D, IN_COLS), D ** -0.5),
        "mu_shift": jax.random.uniform(ks[6], (L, RW_COLS), jnp.float32),
        "w0": nrm(ks[7], (L, RW_WIDTH), 0.5),
        "w2": nrm(ks[8], (L, DECAY_LORA, RW_WIDTH), 0.5 * DECAY_LORA ** -0.5),
        "a0": nrm(ks[9], (L, RW_WIDTH), 0.5),
        "a2": nrm(ks[10], (L, ICLR_LORA, RW_WIDTH), 0.5 * ICLR_LORA ** -0.5),
        "k_k": 0.85 + nrm(ks[11], (L, RW_WIDTH), 0.05),
        "k_a": 1.0 + nrm(ks[12], (L, RW_WIDTH), 0.05),
        "r_k": nrm(ks[13], (L, RW_HEADS, RW_HEAD_DIM), 0.1),
        "lnx_w": 1.0 + nrm(ks[14], (L, RW_WIDTH), 0.1),
        "lnx_b": nrm(ks[15], (L, RW_WIDTH), 0.01),
        "q_norm": 1.0 + nrm(ks[16], (L, AT_HEAD_DIM), 0.1),
        "k_norm": 1.0 + nrm(ks[17], (L, AT_HEAD_DIM), 0.1),
        "sinks": nrm(ks[18], (L, AT_HEADS), 0.5),
        "w_up_r": nrm(ks[19], (L, RW_WIDTH, D), RW_WIDTH ** -0.5),
        "w_up_a": nrm(ks[20], (L, AT_WIDTH, D), AT_WIDTH ** -0.5),
        "w_o": nrm(ks[21], (L, D, D), D ** -0.5),
    }


def reference(x, c, ada_w, ada_b, norm_g, w_in, mu_shift, w0, w2, a0, a2, k_k, k_a, r_k,
              lnx_w, lnx_b, q_norm, k_norm, sinks, w_up_r, w_up_a, w_o):
    for l in range(DEPTH):
        mod = c @ ada_w[l] + ada_b[l]
        shift, scale, gate = jnp.split(mod, 3, axis=-1)
        h = rms_norm(x, norm_g[l]) * (1.0 + scale[:, None, :]) + shift[:, None, :]
        h = h.astype(x.dtype)
        p = h @ w_in[l]
        p_r, p_a, p_g = jnp.split(p, [RW_COLS, RW_COLS + AT_COLS], axis=-1)
        y_r = rwkv7_branch(p_r, mu_shift[l], w0[l], w2[l], a0[l], a2[l], k_k[l], k_a[l], r_k[l],
                           lnx_w[l], lnx_b[l]).astype(x.dtype)
        y_a = swa_sink_branch(p_a, q_norm[l], k_norm[l], sinks[l]).astype(x.dtype)
        g_r, g_a = jnp.split(jax.nn.sigmoid(p_g), N_BRANCH, axis=-1)
        m = g_r * (y_r @ w_up_r[l]) + g_a * (y_a @ w_up_a[l])
        x = x + gate[:, None, :] * (m @ w_o[l])
    return x
```

```cpp
#include <hip/hip_runtime.h>
#include <hip/hip_cooperative_groups.h>
#include <cstdio>
#include <cstdint>
namespace cg = cooperative_groups;

#define REP_MASK 0
#ifndef MK_SPLIT
#define MK_SPLIT 0
#endif

namespace pg8 {
#define PG8_LAS __attribute__((address_space(3)))
typedef unsigned short bf16_t;
typedef short bf16x8 __attribute__((ext_vector_type(8)));
typedef float f32x4 __attribute__((ext_vector_type(4)));
typedef unsigned u32x4 __attribute__((ext_vector_type(4)));
typedef unsigned u32x2 __attribute__((ext_vector_type(2)));
constexpr int BM = 256, BK = 64, HALF = 128, HTB = HALF * BK * 2, STAGE_BYTES = 8 * HTB, NXCD = 8, WGM = 8;

__host__ __device__ __forceinline__ int lds_byte(int r, int c) { const int st = (r >> 4) * 2 + (c >> 5), rr = r & 15, cc = c & 31, ob = rr * 64 + cc * 2; return st * 1024 + (ob ^ (((ob >> 9) & 1) << 5)); }
__host__ __device__ __forceinline__ void stage_rc(int b, int& R, int& C) { const int st = b / 1024, sb = b % 1024, swz = sb ^ (((sb >> 9) & 1) << 5); R = (st >> 1) * 16 + swz / 64; C = (st & 1) * 32 + (swz % 64) / 2; }
__host__ __device__ __forceinline__ int perm32(int rho) { const int n = rho >> 4, i = rho & 15; return 8 * (i >> 2) + 4 * n + (i & 3); }

struct Unit { int pm, pn; };
struct Gemm { const bf16_t* A; const bf16_t* Bt; int M, N, K, lda; };

struct StaticOrder {
    int nM, nN, nwg, G, c;
    __host__ __device__ void init(int M, int N, int G_, int c_) { nM = M / BM; nN = N / BM; nwg = nM * nN; G = G_; c = c_; }
    __host__ __device__ bool next(int i, Unit& u) const {
        const long L = (long)i * G + c; if (L >= nwg) return false;
        int wgid = (int)L; { const int q = nwg / NXCD, r = nwg % NXCD, xcd = wgid % NXCD, off = wgid / NXCD; wgid = (xcd < r ? xcd * (q + 1) : r * (q + 1) + (xcd - r) * q) + off; }
        const int nig = WGM * nN, gid = wgid / nig, fm = gid * WGM, gsz = (nM - fm) < WGM ? (nM - fm) : WGM;
        u.pm = fm + ((wgid % nig) % gsz); u.pn = (wgid % nig) / gsz; return true;
    }
};

__device__ __forceinline__ unsigned cvt_pk_bf16(float lo, float hi) { unsigned r; asm volatile("v_cvt_pk_bf16_f32 %0, %1, %2" : "=v"(r) : "v"(lo), "v"(hi)); return r; }
__device__ __forceinline__ float bflo(unsigned u) { return __uint_as_float(u << 16); }
__device__ __forceinline__ float bfhi(unsigned u) { return __uint_as_float(u & 0xffff0000u); }
__device__ __forceinline__ float sigmoidf_(float v) { return __builtin_amdgcn_rcpf(1.0f + __builtin_amdgcn_exp2f(-1.4426950408889634f * v)); }


struct EpiIn {
    static constexpr bool PERM = true;
    bf16_t *prw, *pat, *pg, *pwa;
    __device__ __forceinline__ void operator()(const f32x4 (&acc)[2][2][4][2], const Unit& u, int wr, int wc, int fr, int fq) const {
        bf16_t* base; int ldc; bool sig = false; const int pn = u.pn;
        if (pn < 16) { base = prw + pn * 256; ldc = 4096; }
        else if (pn < 26) { base = pat + (pn - 16) * 256; ldc = 2560; }
        else if (pn < 42) { base = pg + (pn - 26) * 256; ldc = 4096; sig = true; }
        else { base = pwa; ldc = 256; }
        const int row0 = u.pm * BM + wr * 64 + fr, col0 = wc * 32 + 8 * fq;
#pragma unroll
        for (int ai = 0; ai < 2; ++ai)
#pragma unroll
            for (int m = 0; m < 4; ++m) { bf16_t* rowp = base + (size_t)(row0 + ai * HALF + m * 16) * ldc + col0;
#pragma unroll
                for (int bj = 0; bj < 2; ++bj) { f32x4 v0 = acc[ai][bj][m][0], v1 = acc[ai][bj][m][1];
                    if (sig) {
#pragma unroll
                        for (int e = 0; e < 4; ++e) { v0[e] = sigmoidf_(v0[e]); v1[e] = sigmoidf_(v1[e]); } }
                    u32x4 w; w.x = cvt_pk_bf16(v0[0], v0[1]); w.y = cvt_pk_bf16(v0[2], v0[3]); w.z = cvt_pk_bf16(v1[0], v1[1]); w.w = cvt_pk_bf16(v1[2], v1[3]);
                    *(u32x4*)(rowp + bj * HALF) = w; } }
    }
};

typedef _Float16 h16x8 __attribute__((ext_vector_type(8)));
struct EpiLora {
    static constexpr bool PERM = true;
    _Float16 *wdec, *aa; const float *w0, *a0;
    __device__ __forceinline__ void operator()(const f32x4 (&acc)[2][2][4][2], const Unit& u, int wr, int wc, int fr, int fq) const {
        const bool isdec = u.pn < 4;
        _Float16* base = isdec ? wdec : aa; const float* bias = isdec ? w0 : a0;
        const int colt = (isdec ? u.pn : u.pn - 4) * 256;
        const int row0 = u.pm * BM + wr * 64 + fr, col0 = colt + wc * 32 + 8 * fq;
        f32x4 bv[2][2];
#pragma unroll
        for (int bj = 0; bj < 2; ++bj)
#pragma unroll
            for (int n = 0; n < 2; ++n) bv[bj][n] = *(const f32x4*)(bias + col0 + bj * HALF + 4 * n);
#pragma unroll
        for (int ai = 0; ai < 2; ++ai)
#pragma unroll
            for (int m = 0; m < 4; ++m) { _Float16* rowp = base + (size_t)(row0 + ai * HALF + m * 16) * 1024 + col0;
#pragma unroll
                for (int bj = 0; bj < 2; ++bj) {
                    const f32x4 v0 = acc[ai][bj][m][0] + bv[bj][0], v1 = acc[ai][bj][m][1] + bv[bj][1]; h16x8 o;
#pragma unroll
                    for (int e = 0; e < 8; ++e) { const float v = e < 4 ? v0[e & 3] : v1[e & 3];
                        float r = sigmoidf_(v);
                        if (isdec) r = __builtin_amdgcn_exp2f(-0.6065306597f * 1.4426950408889634f * r);
                        o[e] = (_Float16)r; }
                    *(h16x8*)(rowp + bj * HALF) = o; }
                if (m & 1) asm volatile("" ::: "memory"); }
    }
};

template <bool ADD> struct EpiUp {
    static constexpr bool PERM = true;
    bf16_t* mbuf; const bf16_t* pg; int goff;
    __device__ __forceinline__ void operator()(const f32x4 (&acc)[2][2][4][2], const Unit& u, int wr, int wc, int fr, int fq) const {
        const int row0 = u.pm * BM + wr * 64 + fr, col0 = u.pn * BM + wc * 32 + 8 * fq;
#pragma unroll
        for (int ai = 0; ai < 2; ++ai)
#pragma unroll
            for (int m = 0; m < 4; ++m) { const size_t row = (size_t)(row0 + ai * HALF + m * 16);
#pragma unroll
                for (int bj = 0; bj < 2; ++bj) { const int col = col0 + bj * HALF;
                    const u32x4 g = __builtin_nontemporal_load((const u32x4*)(pg + row * 4096 + goff + col));
                    f32x4 v0 = acc[ai][bj][m][0], v1 = acc[ai][bj][m][1];
                    v0[0] *= bflo(g.x); v0[1] *= bfhi(g.x); v0[2] *= bflo(g.y); v0[3] *= bfhi(g.y);
                    v1[0] *= bflo(g.z); v1[1] *= bfhi(g.z); v1[2] *= bflo(g.w); v1[3] *= bfhi(g.w);
                    if (ADD) { const u32x4 p = __builtin_nontemporal_load((const u32x4*)(mbuf + row * 2048 + col));
                        v0[0] += bflo(p.x); v0[1] += bfhi(p.x); v0[2] += bflo(p.y); v0[3] += bfhi(p.y);
                        v1[0] += bflo(p.z); v1[1] += bfhi(p.z); v1[2] += bflo(p.w); v1[3] += bfhi(p.w); }
                    u32x4 w; w.x = cvt_pk_bf16(v0[0], v0[1]); w.y = cvt_pk_bf16(v0[2], v0[3]); w.z = cvt_pk_bf16(v1[0], v1[1]); w.w = cvt_pk_bf16(v1[2], v1[3]);
                    *(u32x4*)(mbuf + row * 2048 + col) = w; } }
    }
};

struct EpiOut {
    static constexpr bool PERM = false;
    const float* x; float* out; const float* gatef;
    __device__ __forceinline__ void operator()(const f32x4 (&acc)[2][2][4][2], const Unit& u, int wr, int wc, int fr, int fq) const {
        const int row0 = u.pm * BM + wr * 64 + fr, col0 = u.pn * BM + wc * 32 + 4 * fq; const int b = u.pm >> 4;
        f32x4 gv[2][2];
#pragma unroll
        for (int bj = 0; bj < 2; ++bj)
#pragma unroll
            for (int n = 0; n < 2; ++n) gv[bj][n] = *(const f32x4*)(gatef + b * 2048 + col0 + bj * HALF + n * 16);
#pragma unroll
        for (int ai = 0; ai < 2; ++ai)
#pragma unroll
            for (int m = 0; m < 4; ++m) { const size_t off = (size_t)(row0 + ai * HALF + m * 16) * 2048 + col0;
#pragma unroll
                for (int bj = 0; bj < 2; ++bj)
#pragma unroll
                    for (int n = 0; n < 2; ++n) { const f32x4 xv = *(const f32x4*)(x + off + bj * HALF + n * 16);
                        *(f32x4*)(out + off + bj * HALF + n * 16) = xv + gv[bj][n] * acc[ai][bj][m][n]; }
                if (m & 1) asm volatile("" ::: "memory"); }
    }
};

template <class Epi, class Sched, bool ALIGN_EPI>
__device__ __forceinline__ void gemm_phase(PG8_LAS unsigned char* lds, const Gemm g, const Sched& S, const Epi& E) {
    const int tid = threadIdx.x, wid = __builtin_amdgcn_readfirstlane(tid >> 6), lane = tid & 63, wr = wid >> 2, wc = wid & 3, fr = lane & 15, fq = lane >> 4;
    const int K = g.K, nt = K / BK, lda = g.lda;
    unsigned voffA[2], voffB[2];
#pragma unroll
    for (int i = 0; i < 2; ++i) { int R, C; stage_rc(tid * 16 + i * 8192, R, C); const int Rb = Epi::PERM ? ((R & ~31) + perm32(R & 31)) : R;
        voffA[i] = (unsigned)(R * lda + C) * 2u; voffB[i] = (unsigned)(Rb * K + C) * 2u; }
    const size_t kstep = (size_t)(BK * 2);
    const size_t hstepA = (size_t)HALF * lda * 2, hstepB = (size_t)HALF * K * 2;
    const size_t tstepA = 2 * hstepA, tstepB = 2 * hstepB;
    const unsigned ldsw = (unsigned)wid * 1024u;
    const int aoff = lds_byte(wr * 64 + fr, fq * 8), boff = lds_byte(wc * 32 + fr, fq * 8);
#define PG8_SA(b, h) (((b) * 2 + (h)) * HTB)
#define PG8_SB(b, h) ((4 + (b) * 2 + (h)) * HTB)
#define PG8_STAGE(bufoff, gbase, voff) do { _Pragma("unroll") for (int _i = 0; _i < 2; ++_i) \
        __builtin_amdgcn_global_load_lds((const unsigned*)((const char*)(gbase) + (voff)[_i]), (PG8_LAS unsigned*)(lds + (bufoff) + ldsw + _i * 8192), 16, 0, 0); } while (0)
#define PG8_LDA(dst, b, h) do { _Pragma("unroll") for (int m = 0; m < 4; ++m) _Pragma("unroll") for (int k = 0; k < 2; ++k) dst[m][k] = *(const PG8_LAS bf16x8*)(lds + PG8_SA(b, h) + aoff + m * 2048 + k * 1024); } while (0)
#define PG8_LDB(dst, b, h) do { _Pragma("unroll") for (int n = 0; n < 2; ++n) _Pragma("unroll") for (int k = 0; k < 2; ++k) dst[n][k] = *(const PG8_LAS bf16x8*)(lds + PG8_SB(b, h) + boff + n * 2048 + k * 1024); } while (0)
#define PG8_MMA(ai, bj, At, Bt) do { __builtin_amdgcn_s_setprio(1); _Pragma("unroll") for (int m = 0; m < 4; ++m) _Pragma("unroll") for (int n = 0; n < 2; ++n) _Pragma("unroll") for (int k = 0; k < 2; ++k) \
        acc[ai][bj][m][n] = __builtin_amdgcn_mfma_f32_16x16x32_bf16(Bt[n][k], At[m][k], acc[ai][bj][m][n], 0, 0, 0); __builtin_amdgcn_s_setprio(0); } while (0)
#define PG8_WAIT_V(n) asm volatile("s_waitcnt vmcnt(" #n ")" ::: "memory")
#define PG8_WAIT_L(n) asm volatile("s_waitcnt lgkmcnt(" #n ")" ::: "memory")
#define PG8_BAR __builtin_amdgcn_s_barrier()
#define PG8_SCHED __builtin_amdgcn_sched_barrier(0)
    Unit cur, nxt; int ui = 0;
    if (!S.next(0, cur)) return;
    f32x4 acc[2][2][4][2];
#pragma unroll
    for (int a = 0; a < 2; ++a)
#pragma unroll
        for (int b = 0; b < 2; ++b)
#pragma unroll
            for (int m = 0; m < 4; ++m)
#pragma unroll
                for (int n = 0; n < 2; ++n) acc[a][b][m][n] = (f32x4){0.f, 0.f, 0.f, 0.f};
    bf16x8 At[4][2], B0[2][2], B1[2][2];
    const char* cA = (const char*)g.A + (size_t)cur.pm * tstepA; const char* cB = (const char*)g.Bt + (size_t)cur.pn * tstepB;
    PG8_STAGE(PG8_SB(0, 0), cB, voffB); PG8_STAGE(PG8_SB(0, 1), cB + hstepB, voffB); PG8_STAGE(PG8_SA(0, 0), cA, voffA); PG8_STAGE(PG8_SA(0, 1), cA + hstepA, voffA);
    if (wr == 1) PG8_BAR;
    PG8_WAIT_V(2); PG8_BAR;
    PG8_STAGE(PG8_SB(1, 0), cB + kstep, voffB); PG8_STAGE(PG8_SA(1, 0), cA + kstep, voffA); PG8_STAGE(PG8_SB(1, 1), cB + hstepB + kstep, voffB);
    PG8_WAIT_V(6); PG8_BAR;
    for (;;) {
        const bool has_next = S.next(ui + 1, nxt);
        const char* nA = has_next ? (const char*)g.A + (size_t)nxt.pm * tstepA : cA; const char* nB = has_next ? (const char*)g.Bt + (size_t)nxt.pn * tstepB : cB;
        for (int t = 0; t < nt; t += 2) {
            const bool last = (t == nt - 2);
            const char* a1 = cA + (size_t)(t + 1) * kstep;
            const char* a2 = last ? nA : cA + (size_t)(t + 2) * kstep; const char* b2 = last ? nB : cB + (size_t)(t + 2) * kstep;
            const char* a3 = a2 + kstep; const char* b3 = b2 + kstep;
            PG8_LDB(B0, 0, 0); PG8_LDB(B1, 0, 1); PG8_SCHED; PG8_LDA(At, 0, 0); PG8_STAGE(PG8_SA(1, 1), a1 + hstepA, voffA);
            PG8_WAIT_V(8); PG8_WAIT_L(0); PG8_BAR; PG8_MMA(0, 0, At, B0); PG8_MMA(0, 1, At, B1); PG8_BAR; PG8_SCHED;
            PG8_LDA(At, 0, 1); PG8_STAGE(PG8_SB(0, 0), b2, voffB); PG8_STAGE(PG8_SB(0, 1), b2 + hstepB, voffB); PG8_STAGE(PG8_SA(0, 0), a2, voffA);
            PG8_WAIT_V(8); PG8_WAIT_L(0); PG8_BAR; PG8_MMA(1, 0, At, B0); PG8_MMA(1, 1, At, B1); PG8_BAR; PG8_SCHED;
            PG8_LDB(B0, 1, 0); PG8_LDB(B1, 1, 1); PG8_SCHED; PG8_LDA(At, 1, 0); PG8_STAGE(PG8_SA(0, 1), a2 + hstepA, voffA);
            PG8_WAIT_V(8); PG8_WAIT_L(0); PG8_BAR; PG8_MMA(0, 0, At, B0); PG8_MMA(0, 1, At, B1); PG8_BAR; PG8_SCHED;
            PG8_LDA(At, 1, 1); PG8_STAGE(PG8_SB(1, 0), b3, voffB); PG8_STAGE(PG8_SB(1, 1), b3 + hstepB, voffB); PG8_STAGE(PG8_SA(1, 0), a3, voffA);
            PG8_WAIT_V(8); PG8_WAIT_L(0); PG8_BAR; PG8_MMA(1, 0, At, B0); PG8_MMA(1, 1, At, B1); PG8_BAR; PG8_SCHED;
        }
        if constexpr (ALIGN_EPI) { if (wr == 0) PG8_BAR; }
        E(acc, cur, wr, wc, fr, fq);
        if (!has_next) break;
#pragma unroll
        for (int a = 0; a < 2; ++a)
#pragma unroll
            for (int b = 0; b < 2; ++b)
#pragma unroll
                for (int m = 0; m < 4; ++m)
#pragma unroll
                    for (int n = 0; n < 2; ++n) acc[a][b][m][n] = (f32x4){0.f, 0.f, 0.f, 0.f};
        cur = nxt; cA = nA; cB = nB; ++ui;
        if constexpr (ALIGN_EPI) { if (wr == 1) PG8_BAR; }
    }
    PG8_WAIT_V(0);
    if constexpr (!ALIGN_EPI) { if (wr == 0) PG8_BAR; }
    PG8_BAR;
#undef PG8_SA
#undef PG8_SB
#undef PG8_STAGE
#undef PG8_LDA
#undef PG8_LDB
#undef PG8_MMA
#undef PG8_WAIT_V
#undef PG8_WAIT_L
#undef PG8_BAR
#undef PG8_SCHED
}
}

#define LAS __attribute__((address_space(3)))
typedef unsigned short bf16;
typedef float f32x4 __attribute__((ext_vector_type(4)));
typedef float f32x16 __attribute__((ext_vector_type(16)));
typedef unsigned u32x4 __attribute__((ext_vector_type(4)));
typedef unsigned u32x2 __attribute__((ext_vector_type(2)));
typedef short bf16x8 __attribute__((ext_vector_type(8)));
typedef _Float16 h16x4 __attribute__((ext_vector_type(4)));
typedef _Float16 h16x8 __attribute__((ext_vector_type(8)));

constexpr int NWAVES = 8, NTHR = 512;
constexpr int D = 2048, BATCH = 4, SEQ = 4096, M = BATCH * SEQ;
constexpr int RW = 1024, RW_COLS = 4224, AT_COLS = 2560, IN_COLS = 10880, NPAD = 11008;
constexpr size_t MiB = 1u << 20;
constexpr size_t WS_MODP = 0;
constexpr size_t WS_GATEF = 1 * MiB + MiB / 2;
constexpr size_t WS_BAR = 1 * MiB + MiB / 2 + 65536;
constexpr size_t WS_BONUS = 2 * MiB;
constexpr size_t WS_WLORA = 3 * MiB;
constexpr size_t WS_WUPR = 4 * MiB, WS_WUPA = 8 * MiB, WS_WO = 12 * MiB;
constexpr size_t WS_PRW = 20 * MiB;
constexpr size_t WS_PAT = 148 * MiB;
constexpr size_t WS_PG = 228 * MiB;
constexpr size_t WS_PWA = 356 * MiB;
constexpr size_t WS_H = 364 * MiB;
constexpr size_t WS_WIN = 428 * MiB;
constexpr size_t WS_A2 = 364 * MiB;
constexpr size_t WS_WDEC = 368 * MiB, WS_KK = 400 * MiB, WS_AA = 432 * MiB;
constexpr size_t WS_YRAW = 464 * MiB;
constexpr size_t WS_MB = 368 * MiB;
constexpr size_t WS_END = 512 * MiB;
constexpr int LDS_BYTES = 147456;
constexpr int LDS_MISC = 147200;

struct Args {
    const float *x, *c, *ada_w, *ada_b, *norm_g, *w_in, *mu, *w0, *w2, *a0, *a2, *k_k, *k_a, *r_k, *lnx_w, *lnx_b, *q_norm, *k_norm, *sinks, *w_up_r, *w_up_a, *w_o;
    float* out; unsigned char* ws; int ph_lo, ph_hi, rep_mask, pad;
};

__device__ __forceinline__ unsigned f2bf(float f) { unsigned u = __builtin_bit_cast(unsigned, f); return (u + 0x7fffu + ((u >> 16) & 1u)) >> 16; }
__device__ __forceinline__ unsigned pk2(float lo, float hi) { return pg8::cvt_pk_bf16(lo, hi); }
__device__ __forceinline__ float bflo(unsigned u) { return __uint_as_float(u << 16); }
__device__ __forceinline__ float bfhi(unsigned u) { return __uint_as_float(u & 0xffff0000u); }
__device__ __forceinline__ float wave_sum(float v) {
#pragma unroll
    for (int o = 1; o < 64; o <<= 1) v += __shfl_xor(v, o);
    return v;
}
template <int CTRL> __device__ __forceinline__ float dpp_f(float x) { return __int_as_float(__builtin_amdgcn_update_dpp(0, __float_as_int(x), CTRL, 0xf, 0xf, false)); }
__device__ __forceinline__ float row16_sum(float x) {
    x += dpp_f<0x128>(x); x += dpp_f<0x124>(x); x += dpp_f<0x122>(x); x += dpp_f<0x121>(x); return x;
}
__device__ __forceinline__ void unpack8(const u32x4 v, float* f) { f[0] = bflo(v.x); f[1] = bfhi(v.x); f[2] = bflo(v.y); f[3] = bfhi(v.y); f[4] = bflo(v.z); f[5] = bfhi(v.z); f[6] = bflo(v.w); f[7] = bfhi(v.w); }

__device__ __forceinline__ void p0_transpose_item(const float* W, int Nsrc, int sc0, int k0, bf16* WT, int Kdst, int dr0, bool zero, LAS float* scr, int lane) {
    if (!zero) {
#pragma unroll 8
        for (int i = 0; i < 32; ++i) { const int kk = 2 * i + (lane >> 5); scr[kk * 33 + (lane & 31)] = __builtin_nontemporal_load(W + (size_t)(k0 + kk) * Nsrc + sc0 + (lane & 31)); }
    }
    asm volatile("s_waitcnt lgkmcnt(0)" ::: "memory");
    const int c = lane & 7;
#pragma unroll
    for (int j = 0; j < 4; ++j) { const int n = (lane >> 3) + 8 * j; const LAS float* s = scr + (8 * c) * 33 + n;
        u32x4 o;
        if (zero) { o = (u32x4){0u, 0u, 0u, 0u}; }
        else { o.x = pk2(s[0 * 33], s[1 * 33]); o.y = pk2(s[2 * 33], s[3 * 33]); o.z = pk2(s[4 * 33], s[5 * 33]); o.w = pk2(s[6 * 33], s[7 * 33]); }
        *(u32x4*)(WT + (size_t)(dr0 + n) * Kdst + k0 + 8 * c) = o; }
    asm volatile("s_waitcnt lgkmcnt(0)" ::: "memory");
}
__device__ __forceinline__ int win_src_col(int n0) {
    if (n0 < 4096) return n0;
    if (n0 < 6656) return 4224 + (n0 - 4096);
    if (n0 < 10752) return 6784 + (n0 - 6656);
    return 4096 + (n0 - 10752);
}
__device__ __forceinline__ void p0_phase(const Args& a, LAS unsigned char* lds, int tid, int lane, int wave) {
    unsigned char* ws = a.ws;
    const int gw = blockIdx.x * NWAVES + wave, NGW = gridDim.x * NWAVES;
    for (int task = wave * (int)gridDim.x + (int)blockIdx.x; task < 16 * 24; task += NGW) {
        const int kc = task / 24, cgp = task % 24, col = cgp * 256 + lane * 4;
        f32x4 acc[4]; float c0[4], c1[4];
#pragma unroll
        for (int b = 0; b < 4; ++b) { acc[b] = (f32x4){0.f, 0.f, 0.f, 0.f}; c0[b] = a.c[b * 2048 + kc * 128 + lane]; c1[b] = a.c[b * 2048 + kc * 128 + 64 + lane]; }
        const float* wp = a.ada_w + (size_t)(kc * 128) * 6144 + col;
#pragma unroll 8
        for (int k = 0; k < 64; ++k) { const f32x4 w = __builtin_nontemporal_load((const f32x4*)(wp + (size_t)k * 6144));
#pragma unroll
            for (int b = 0; b < 4; ++b) acc[b] += w * __builtin_bit_cast(float, __builtin_amdgcn_readlane(__builtin_bit_cast(int, c0[b]), k)); }
#pragma unroll 8
        for (int k = 0; k < 64; ++k) { const f32x4 w = __builtin_nontemporal_load((const f32x4*)(wp + (size_t)(64 + k) * 6144));
#pragma unroll
            for (int b = 0; b < 4; ++b) acc[b] += w * __builtin_bit_cast(float, __builtin_amdgcn_readlane(__builtin_bit_cast(int, c1[b]), k)); }
        float* mp = (float*)(ws + WS_MODP) + (size_t)kc * 4 * 6144 + col;
#pragma unroll
        for (int b = 0; b < 4; ++b) *(f32x4*)(mp + b * 6144) = acc[b];
    }
    LAS float* scr = (LAS float*)(lds + wave * 16384);
    constexpr int I_IN = 32 * (NPAD / 32), I_UP = 16 * 64, I_O = 32 * 64, NITEMS = I_IN + 2 * I_UP + I_O;
    for (int it = (wave - 2) * (int)gridDim.x + (int)blockIdx.x; wave >= 2 && it < NITEMS; it += 6 * (int)gridDim.x) {
        int r = it;
        if (r < I_IN) { const int nblk = NPAD / 32, kb = r / nblk, nb = r % nblk, n0 = nb * 32; const bool z = n0 >= IN_COLS;
            p0_transpose_item(a.w_in, IN_COLS, z ? 0 : win_src_col(n0), kb * 64, (bf16*)(ws + WS_WIN), 2048, n0, z, scr, lane); continue; }
        r -= I_IN;
        if (r < I_UP) { const int kb = r / 64, nb = r % 64; p0_transpose_item(a.w_up_r, 2048, nb * 32, kb * 64, (bf16*)(ws + WS_WUPR), 1024, nb * 32, false, scr, lane); continue; }
        r -= I_UP;
        if (r < I_UP) { const int kb = r / 64, nb = r % 64; p0_transpose_item(a.w_up_a, 2048, nb * 32, kb * 64, (bf16*)(ws + WS_WUPA), 1024, nb * 32, false, scr, lane); continue; }
        r -= I_UP;
        { const int kb = r / 64, nb = r % 64; p0_transpose_item(a.w_o, 2048, nb * 32, kb * 64, (bf16*)(ws + WS_WO), 2048, nb * 32, false, scr, lane); }
    }
    bf16* wl = (bf16*)(ws + WS_WLORA);
    for (int idx = blockIdx.x * NTHR + tid; idx < 2048 * 128; idx += gridDim.x * NTHR) {
        const int n = idx >> 7, k = idx & 127; float v = 0.f;
        if (n < 1024) { if (k < 64) v = a.w2[k * 1024 + n]; } else { if (k >= 64) v = a.a2[(k - 64) * 1024 + (n - 1024)]; }
        wl[idx] = (bf16)f2bf(v);
    }
}

__device__ __forceinline__ void p1_phase(const Args& a, LAS unsigned char* lds, int tid, int lane, int wave) {
    unsigned char* ws = a.ws;
    LAS float* mul = (LAS float*)lds; LAS float* add = mul + 2048;
    const float* modp = (const float*)(ws + WS_MODP);
    if (blockIdx.x < 4) {
        const int b = blockIdx.x, col = tid * 4; f32x4 s = *(const f32x4*)(a.ada_b + 4096 + col);
        for (int kc = 0; kc < 16; ++kc) s += *(const f32x4*)(modp + ((size_t)kc * 4 + b) * 6144 + 4096 + col);
        *(f32x4*)((float*)(ws + WS_GATEF) + b * 2048 + col) = s;
    }
    for (int rb = blockIdx.x; rb < M / 64; rb += gridDim.x) {
        const int b = rb / 64;
        __syncthreads();
        { const int col = tid * 4; f32x4 sh = *(const f32x4*)(a.ada_b + col), sc = *(const f32x4*)(a.ada_b + 2048 + col);
            for (int kc = 0; kc < 16; ++kc) { const float* p = modp + ((size_t)kc * 4 + b) * 6144; sh += *(const f32x4*)(p + col); sc += *(const f32x4*)(p + 2048 + col); }
            const f32x4 g = *(const f32x4*)(a.norm_g + col);
#pragma unroll
            for (int e = 0; e < 4; ++e) { mul[col + e] = g[e] * (1.0f + sc[e]); add[col + e] = sh[e]; } }
        __syncthreads();
        for (int i = 0; i < 8; ++i) {
            const int m = rb * 64 + wave * 8 + i;
            const f32x4* xr = (const f32x4*)(a.x + (size_t)m * D) + lane;
            f32x4 v[8]; float s = 0.f;
#pragma unroll
            for (int j = 0; j < 8; ++j) { v[j] = __builtin_nontemporal_load(xr + 64 * j); s += (v[j].x * v[j].x + v[j].y * v[j].y) + (v[j].z * v[j].z + v[j].w * v[j].w); }
            const float rstd = 1.0f / sqrtf(wave_sum(s) * (1.0f / D) + 1e-6f);
            unsigned long long* o8 = (unsigned long long*)((bf16*)(ws + WS_H) + (size_t)m * D) + lane;
#pragma unroll
            for (int j = 0; j < 8; ++j) { const int col = 4 * lane + 256 * j;
                const float h0 = v[j].x * rstd * mul[col] + add[col], h1 = v[j].y * rstd * mul[col + 1] + add[col + 1], h2 = v[j].z * rstd * mul[col + 2] + add[col + 2], h3 = v[j].w * rstd * mul[col + 3] + add[col + 3];
                o8[64 * j] = (unsigned long long)pk2(h0, h1) | ((unsigned long long)pk2(h2, h3) << 32); }
        }
    }
}

__device__ __forceinline__ void p3_phase(const Args& a, int lane, int wave) {
    unsigned char* ws = a.ws;
    const bf16* pwa = (const bf16*)(ws + WS_PWA);
    bf16* a2 = (bf16*)(ws + WS_A2);
    const int gw = blockIdx.x * NWAVES + wave, NGW = gridDim.x * NWAVES;
    const float muw0 = a.mu[4096 + 2 * lane], muw1 = a.mu[4096 + 2 * lane + 1];
    for (int m = gw; m < M; m += NGW) {
        const bool first = (m % SEQ) == 0;
        const unsigned wc = *(const unsigned*)(pwa + (size_t)m * 256 + 2 * lane);
        const unsigned wp = first ? 0u : *(const unsigned*)(pwa + (size_t)(m - 1) * 256 + 2 * lane);
        float v0 = bflo(wc), v1 = bfhi(wc);
        v0 += (bflo(wp) - v0) * muw0; v1 += (bfhi(wp) - v1) * muw1;
        if (lane < 32) { v0 = tanhf(v0); v1 = tanhf(v1); }
        *(unsigned*)(a2 + (size_t)m * 128 + 2 * lane) = pk2(v0, v1);
    }
}

namespace att {
constexpr int KP = 72, VP = 260, SP = 72;
constexpr int LDS_K = 0, LDS_V = 256 * KP * 2, LDS_S = LDS_V + 64 * VP * 2, LDS_TOTAL = LDS_S + 8 * 32 * SP * 2;
__device__ __forceinline__ int crow(int r, int hi) { return (r & 3) + 8 * (r >> 2) + 4 * hi; }
__device__ __forceinline__ void phase(const Args& a, LAS unsigned char* lds, int tid, int lane, int wave) {
    unsigned char* ws = a.ws;
    bf16* pat = (bf16*)(ws + WS_PAT);
    const int r32 = lane & 31, hi = lane >> 5;
    const int ch = tid & 7;
    float knw[8], qnw[8];
#pragma unroll
    for (int e = 0; e < 8; ++e) { knw[e] = a.k_norm[8 * ch + e]; qnw[e] = a.q_norm[8 * ch + e] * 0.125f; }
    LAS unsigned char* stg = lds + LDS_S + wave * (32 * SP * 2);
    for (int unit = blockIdx.x; unit < 512; unit += gridDim.x) {
        const int b = unit >> 7, kh = (unit >> 5) & 3, n = unit & 31;
        const int m0 = b * SEQ + n * 128;
        __syncthreads();
#pragma unroll
        for (int i = 0; i < 4; ++i) {
            const int s = (tid >> 3) + 64 * i; const bool valid = (n > 0) || (s >= 128);
            const bf16* src = pat + (size_t)(m0 - 128 + s) * 2560 + 2048 + kh * 64 + 8 * ch;
            float kf[8], vf[8];
            if (valid) { unpack8(*(const u32x4*)src, kf); unpack8(*(const u32x4*)(src + 256), vf); }
            else {
#pragma unroll
                for (int e = 0; e < 8; ++e) { kf[e] = 0.f; vf[e] = 0.f; }
            }
            float ss = 0.f;
#pragma unroll
            for (int e = 0; e < 8; ++e) ss += kf[e] * kf[e];
            ss += __shfl_xor(ss, 1); ss += __shfl_xor(ss, 2); ss += __shfl_xor(ss, 4);
            const float rstd = 1.0f / sqrtf(ss * (1.0f / 64.0f) + 1e-6f);
            u32x4 w;
            w.x = pk2(kf[0] * rstd * knw[0], kf[1] * rstd * knw[1]); w.y = pk2(kf[2] * rstd * knw[2], kf[3] * rstd * knw[3]);
            w.z = pk2(kf[4] * rstd * knw[4], kf[5] * rstd * knw[5]); w.w = pk2(kf[6] * rstd * knw[6], kf[7] * rstd * knw[7]);
            *(LAS u32x4*)(lds + LDS_K + (s * KP + 8 * ch) * 2) = w;
            LAS bf16* vt = (LAS bf16*)(lds + LDS_V);
#pragma unroll
            for (int e = 0; e < 8; ++e) vt[(8 * ch + e) * VP + s] = (bf16)f2bf(vf[e]);
        }
        __syncthreads();
#pragma unroll 1
        for (int it = 0; it < 2; ++it) {
            const int task = wave + 8 * it, g = task >> 2, qq = task & 3, hq = kh * 4 + g;
            bf16* qbase = pat + (size_t)(m0 + 32 * qq) * 2560 + hq * 64;
#pragma unroll
            for (int i = 0; i < 4; ++i) { const int row = (lane >> 3) + 8 * i; float qv[8];
                unpack8(__builtin_nontemporal_load((const u32x4*)(qbase + (size_t)row * 2560 + 8 * ch)), qv);
                u32x4 w; w.x = pk2(qv[0] * qnw[0], qv[1] * qnw[1]); w.y = pk2(qv[2] * qnw[2], qv[3] * qnw[3]); w.z = pk2(qv[4] * qnw[4], qv[5] * qnw[5]); w.w = pk2(qv[6] * qnw[6], qv[7] * qnw[7]);
                float s2 = 0.f;
#pragma unroll
                for (int e = 0; e < 8; ++e) s2 += qv[e] * qv[e];
                s2 += __shfl_xor(s2, 1); s2 += __shfl_xor(s2, 2); s2 += __shfl_xor(s2, 4);
                *(LAS u32x4*)(stg + (row * SP + 8 * ch) * 2) = w;
                if (ch == 0) *(LAS float*)(stg + (row * SP + 64) * 2) = 1.0f / sqrtf(s2 * (1.0f / 64.0f) + 1e-6f);
            }
            asm volatile("s_waitcnt lgkmcnt(0)" ::: "memory");
            bf16x8 qb[4];
#pragma unroll
            for (int ks = 0; ks < 4; ++ks) qb[ks] = *(const LAS bf16x8*)(stg + (r32 * SP + 16 * ks + 8 * hi) * 2);
            const float qrs = *(const LAS float*)(stg + (r32 * SP + 64) * 2);
            f32x16 sc[5];
#pragma unroll
            for (int kt = 0; kt < 5; ++kt) {
#pragma unroll
                for (int r = 0; r < 16; ++r) sc[kt][r] = 0.f;
                const LAS unsigned char* kb = lds + LDS_K + ((32 * (qq + kt) + r32) * KP + 8 * hi) * 2;
#pragma unroll
                for (int ks = 0; ks < 4; ++ks) { const bf16x8 kfr = *(const LAS bf16x8*)(kb + 32 * ks);
                    sc[kt] = __builtin_amdgcn_mfma_f32_32x32x16_bf16(kfr, qb[ks], sc[kt], 0, 0, 0); }
            }
            const float sink = a.sinks[hq];
            float mx = sink;
#pragma unroll
            for (int kt = 0; kt < 5; ++kt)
#pragma unroll
                for (int r = 0; r < 16; ++r) { const int s = 32 * (qq + kt) + crow(r, hi); const int diff = 32 * qq + r32 + 128 - s;
                    const bool ok = (diff >= 0) && (diff < 128) && ((n > 0) || (s >= 128));
                    sc[kt][r] = ok ? sc[kt][r] * qrs : -1e30f; mx = fmaxf(mx, sc[kt][r]); }
            mx = fmaxf(mx, __shfl_xor(mx, 32));
            float l = 0.f;
#pragma unroll
            for (int kt = 0; kt < 5; ++kt)
#pragma unroll
                for (int r = 0; r < 16; ++r) { const float p = __expf(sc[kt][r] - mx); sc[kt][r] = p; l += p; }
            l += __shfl_xor(l, 32);
            l += __expf(sink - mx);
            f32x16 o[2];
#pragma unroll
            for (int dt = 0; dt < 2; ++dt)
#pragma unroll
                for (int r = 0; r < 16; ++r) o[dt][r] = 0.f;
#pragma unroll
            for (int kt = 0; kt < 5; ++kt)
#pragma unroll
                for (int s2 = 0; s2 < 2; ++s2) {
                    u32x4 pw; pw.x = pk2(sc[kt][8 * s2 + 0], sc[kt][8 * s2 + 1]); pw.y = pk2(sc[kt][8 * s2 + 2], sc[kt][8 * s2 + 3]);
                    pw.z = pk2(sc[kt][8 * s2 + 4], sc[kt][8 * s2 + 5]); pw.w = pk2(sc[kt][8 * s2 + 6], sc[kt][8 * s2 + 7]);
                    const bf16x8 pf = __builtin_bit_cast(bf16x8, pw);
                    const int keyb = 32 * (qq + kt) + 16 * s2 + 4 * hi;
#pragma unroll
                    for (int dt = 0; dt < 2; ++dt) {
                        const LAS unsigned char* vb = lds + LDS_V + ((32 * dt + r32) * VP + keyb) * 2;
                        const u32x2 lo = *(const LAS u32x2*)vb, hh = *(const LAS u32x2*)(vb + 16);
                        const u32x4 vv = (u32x4){lo.x, lo.y, hh.x, hh.y};
                        o[dt] = __builtin_amdgcn_mfma_f32_32x32x16_bf16(__builtin_bit_cast(bf16x8, vv), pf, o[dt], 0, 0, 0); }
                }
            const float rl = 1.0f / l;
#pragma unroll
            for (int dt = 0; dt < 2; ++dt)
#pragma unroll
                for (int g4 = 0; g4 < 4; ++g4) { const int d0 = 32 * dt + 8 * g4 + 4 * hi;
                    u32x2 w; w.x = pk2(o[dt][4 * g4 + 0] * rl, o[dt][4 * g4 + 1] * rl); w.y = pk2(o[dt][4 * g4 + 2] * rl, o[dt][4 * g4 + 3] * rl);
                    *(LAS u32x2*)(stg + (r32 * SP + d0) * 2) = w; }
            asm volatile("s_waitcnt lgkmcnt(0)" ::: "memory");
#pragma unroll
            for (int i = 0; i < 4; ++i) { const int row = (lane >> 3) + 8 * i; float ov[8], gv[8];
                bf16* rp = qbase + (size_t)row * 2560 + 8 * ch;
                unpack8(*(const LAS u32x4*)(stg + (row * SP + 8 * ch) * 2), ov); unpack8(__builtin_nontemporal_load((const u32x4*)(rp + 1024)), gv);
#pragma unroll
                for (int e = 0; e < 8; ++e) ov[e] = ov[e] * gv[e] * pg8::sigmoidf_(gv[e]);
                u32x4 w; w.x = pk2(ov[0], ov[1]); w.y = pk2(ov[2], ov[3]); w.z = pk2(ov[4], ov[5]); w.w = pk2(ov[6], ov[7]);
                *(u32x4*)rp = w; }
            asm volatile("s_waitcnt lgkmcnt(0)" ::: "memory");
        }
    }
    __syncthreads();
}
}

namespace scan {
constexpr int TT = 32, NT = SEQ / TT;
constexpr int OFF_R = 0, OFF_W = 2048, OFF_K = 4096, OFF_A = 6144, OFF_B = 8192, OFF_V = 10240, OFF_Y = 10752, BUF_F = 12800;
typedef float lf4 __attribute__((ext_vector_type(4)));
typedef float lf2 __attribute__((ext_vector_type(2)));

struct StageCtx { const bf16* prw; const _Float16 *aab, *wdb; float* bonus; bf16* yraw; int b, hh, quarter; float mur[4], muk[4], muv[4], ka[4], rk[4], kkw[4]; };
struct Raw { u32x2 r0, k0, v0, r1, k1, v1; h16x4 aa, wd; };
struct Ops { lf4 a, b, w, k, r; float v; };

__device__ __forceinline__ void stage_load(const StageCtx& c, int tau, int ht, Raw (&raw)[2]) {
#pragma unroll
    for (int i = 0; i < 2; ++i) {
        const int idx = ht + 256 * i, t = idx >> 4, c4 = (idx & 15) * 4, tt = tau * TT + t;
        const size_t m = (size_t)c.b * SEQ + tt; const int ch = c.hh * 64 + c4;
        const bf16* p = c.prw + m * 4096 + ch;
        raw[i].r0 = *(const u32x2*)p; raw[i].k0 = *(const u32x2*)(p + 1024); raw[i].v0 = *(const u32x2*)(p + 2048);
        const bf16* pp = (tt > 0) ? p - 4096 : p;
        raw[i].r1 = *(const u32x2*)pp; raw[i].k1 = *(const u32x2*)(pp + 1024); raw[i].v1 = *(const u32x2*)(pp + 2048);
        raw[i].aa = *(const h16x4*)(c.aab + m * 1024 + ch); raw[i].wd = *(const h16x4*)(c.wdb + m * 1024 + ch);
    }
}
__device__ __forceinline__ void stage_conv(const StageCtx& c, int tau, LAS float* buf, int ht, const Raw (&raw)[2]) {
#pragma unroll
    for (int i = 0; i < 2; ++i) {
        const int idx = ht + 256 * i, t = idx >> 4, c4 = (idx & 15) * 4, tt = tau * TT + t;
        const size_t m = (size_t)c.b * SEQ + tt;
        const float pz = (tt > 0) ? 1.0f : 0.0f;
        const u32x2 r0 = raw[i].r0, k0 = raw[i].k0, v0 = raw[i].v0, r1 = raw[i].r1, k1 = raw[i].k1, v1 = raw[i].v1;
        const float rc[4] = {bflo(r0.x), bfhi(r0.x), bflo(r0.y), bfhi(r0.y)}, rp[4] = {bflo(r1.x), bfhi(r1.x), bflo(r1.y), bfhi(r1.y)};
        const float kc[4] = {bflo(k0.x), bfhi(k0.x), bflo(k0.y), bfhi(k0.y)}, kp[4] = {bflo(k1.x), bfhi(k1.x), bflo(k1.y), bfhi(k1.y)};
        const float vc[4] = {bflo(v0.x), bfhi(v0.x), bflo(v0.y), bfhi(v0.y)}, vp[4] = {bflo(v1.x), bfhi(v1.x), bflo(v1.y), bfhi(v1.y)};
        lf4 R, W, K, A, Bv, V; float bon = 0.f, ks4[4], kk4[4], ss = 0.f;
#pragma unroll
        for (int e = 0; e < 4; ++e) { ks4[e] = kc[e] + (kp[e] * pz - kc[e]) * c.muk[e]; kk4[e] = ks4[e] * c.kkw[e]; ss += kk4[e] * kk4[e]; }
        ss = row16_sum(ss);
        const float kinv = 1.0f / fmaxf(sqrtf(ss), 1e-12f);
#pragma unroll
        for (int e = 0; e < 4; ++e) {
            const float rs = rc[e] + (rp[e] * pz - rc[e]) * c.mur[e], ks = ks4[e], vs = vc[e] + (vp[e] * pz - vc[e]) * c.muv[e];
            const float aa = (float)raw[i].aa[e], kk = kk4[e] * kinv;
            const float kn = ks * (1.0f + (aa - 1.0f) * c.ka[e]);
            R[e] = rs; W[e] = (float)raw[i].wd[e]; K[e] = kn; A[e] = -kk; Bv[e] = kk * aa; V[e] = vs; bon += rs * kn * c.rk[e];
        }
        *(LAS lf4*)(buf + OFF_R + t * 64 + c4) = R; *(LAS lf4*)(buf + OFF_W + t * 64 + c4) = W; *(LAS lf4*)(buf + OFF_K + t * 64 + c4) = K;
        *(LAS lf4*)(buf + OFF_A + t * 64 + c4) = A; *(LAS lf4*)(buf + OFF_B + t * 64 + c4) = Bv;
        if ((c4 >> 4) == c.quarter) *(LAS lf4*)(buf + OFF_V + t * 16 + (c4 & 15)) = V;
        bon = row16_sum(bon);
        if (c.quarter == 0 && (ht & 15) == 0) c.bonus[m * 16 + c.hh] = bon;
    }
}
__device__ __forceinline__ void write_y(const StageCtx& c, int tau, const LAS float* buf, int ht) {
    const int idx = ht * 2, t = idx >> 4, ii = idx & 15;
    const size_t m = (size_t)c.b * SEQ + tau * TT + t;
    const lf4 p0 = *(const LAS lf4*)(buf + OFF_Y + idx * 4), p1 = *(const LAS lf4*)(buf + OFF_Y + idx * 4 + 4);
    const float y0 = (p0.x + p0.y) + (p0.z + p0.w), y1 = (p1.x + p1.y) + (p1.z + p1.w);
    *(unsigned*)(c.yraw + m * 1024 + c.hh * 64 + c.quarter * 16 + ii) = pk2(y0, y1);
}

__device__ __forceinline__ void phase(const Args& a, LAS unsigned char* lds, int tid, int lane, int wave) {
    unsigned char* ws = a.ws;
    LAS float* bufs = (LAS float*)lds;
    for (int unit = blockIdx.x; unit < 256; unit += gridDim.x) {
        StageCtx c; c.prw = (const bf16*)(ws + WS_PRW); c.aab = (const _Float16*)(ws + WS_AA); c.wdb = (const _Float16*)(ws + WS_WDEC);
        c.bonus = (float*)(ws + WS_BONUS); c.yraw = (bf16*)(ws + WS_YRAW);
        const int bh = unit >> 2; c.quarter = unit & 3; c.b = bh >> 4; c.hh = bh & 15;
        const int ht = tid - 256;
        Raw raw[2];
        __syncthreads();
        if (wave >= 4) {
            const int ch = c.hh * 64 + (ht & 15) * 4;
#pragma unroll
            for (int e = 0; e < 4; ++e) { c.mur[e] = a.mu[ch + e]; c.muk[e] = a.mu[1024 + ch + e]; c.muv[e] = a.mu[2048 + ch + e]; c.ka[e] = a.k_a[ch + e]; c.rk[e] = a.r_k[ch + e]; c.kkw[e] = a.k_k[ch + e]; }
            stage_load(c, 0, ht, raw); stage_conv(c, 0, bufs, ht, raw); stage_load(c, 1, ht, raw);
        }
        __syncthreads();
        lf2 S01 = (lf2){0.f, 0.f}, S23 = (lf2){0.f, 0.f};
        const int rg = lane >> 4, cgp = lane & 15, rloc = (wave & 3) * 4 + rg;
#pragma unroll 1
        for (int tau = 0; tau < NT; ++tau) {
            LAS float* cur = bufs + (tau & 1) * BUF_F; LAS float* nxt = bufs + ((tau + 1) & 1) * BUF_F;
            if (wave < 4) {
                const LAS lf4* R4 = (const LAS lf4*)(cur + OFF_R) + cgp; const LAS lf4* W4 = (const LAS lf4*)(cur + OFF_W) + cgp; const LAS lf4* K4 = (const LAS lf4*)(cur + OFF_K) + cgp;
                const LAS lf4* A4 = (const LAS lf4*)(cur + OFF_A) + cgp; const LAS lf4* B4 = (const LAS lf4*)(cur + OFF_B) + cgp;
                const LAS float* Vp = cur + OFF_V + rloc; LAS float* Yp = cur + OFF_Y + rloc * 4 + (cgp & 3);
#define SC_LOAD(dst, g) do { _Pragma("unroll") for (int s_ = 0; s_ < GS; ++s_) { const int t_ = (g) * GS + s_; dst[s_].a = A4[t_ * 16]; dst[s_].b = B4[t_ * 16]; dst[s_].w = W4[t_ * 16]; \
                    dst[s_].k = K4[t_ * 16]; dst[s_].r = R4[t_ * 16]; dst[s_].v = Vp[t_ * 16]; } } while (0)
#define SC_STEPS(src, g) do { _Pragma("unroll") for (int s_ = 0; s_ < GS; ++s_) { const Ops& o_ = src[s_]; \
                    lf2 p = S01 * o_.a.xy; p = S23 * o_.a.zw + p; \
                    lf2 t01 = S01 * o_.w.xy; t01 = o_.k.xy * o_.v + t01; lf2 t23 = S23 * o_.w.zw; t23 = o_.k.zw * o_.v + t23; \
                    const float sa = row16_sum(p.x + p.y); \
                    S01 = o_.b.xy * sa + t01; S23 = o_.b.zw * sa + t23; \
                    lf2 q = S01 * o_.r.xy; q = S23 * o_.r.zw + q; \
                    float y = q.x + q.y; y += dpp_f<0x128>(y); y += dpp_f<0x124>(y); \
                    Yp[((g) * GS + s_) * 64] = y; } } while (0)
                constexpr int GS = 2; Ops oa[GS], ob[GS];
                SC_LOAD(oa, 0);
#pragma unroll 2
                for (int g = 0; g < TT / GS; g += 2) {
                    SC_LOAD(ob, g + 1);
                    SC_STEPS(oa, g);
                    const int g2 = (g + 2 < TT / GS) ? g + 2 : g;
                    SC_LOAD(oa, g2);
                    SC_STEPS(ob, g + 1);
                }
#undef SC_LOAD
#undef SC_STEPS
            } else {
                if (tau + 1 < NT) stage_conv(c, tau + 1, nxt, ht, raw);
                if (tau + 2 < NT) stage_load(c, tau + 2, ht, raw);
                if (tau >= 1) write_y(c, tau - 1, nxt, ht);
            }
            __syncthreads();
        }
        if (wave >= 4) write_y(c, NT - 1, bufs + ((NT - 1) & 1) * BUF_F, ht);
    }
    __syncthreads();
}
}

__device__ __forceinline__ void p6_phase(const Args& a, int lane, int wave) {
    unsigned char* ws = a.ws;
    bf16* prw = (bf16*)(ws + WS_PRW); const bf16* yraw = (const bf16*)(ws + WS_YRAW); const float* bonus = (const float*)(ws + WS_BONUS);
    const int gw = blockIdx.x * NWAVES + wave, NGW = gridDim.x * NWAVES;
    const int c0 = 16 * lane;
    float muv[16], mug[16], lw[16], lb[16];
#pragma unroll
    for (int e = 0; e < 16; ++e) { muv[e] = a.mu[2048 + c0 + e]; mug[e] = a.mu[3072 + c0 + e]; lw[e] = a.lnx_w[c0 + e]; lb[e] = a.lnx_b[c0 + e]; }
    for (int m0 = gw * 8; m0 < M; m0 += NGW * 8)
    for (int m = m0; m < m0 + 8; ++m) {
        const bool first = (m % SEQ) == 0;
        float y[16], vc[16], vp[16], gc[16], gp[16];
        const bf16* yp = yraw + (size_t)m * 1024 + c0;
        unpack8(__builtin_nontemporal_load((const u32x4*)yp), y); unpack8(__builtin_nontemporal_load((const u32x4*)(yp + 8)), y + 8);
        const bf16* pr = prw + (size_t)m * 4096 + c0;
        unpack8(*(const u32x4*)(pr + 2048), vc); unpack8(*(const u32x4*)(pr + 2048 + 8), vc + 8);
        unpack8(*(const u32x4*)(pr + 3072), gc); unpack8(*(const u32x4*)(pr + 3072 + 8), gc + 8);
        if (first) {
#pragma unroll
            for (int e = 0; e < 16; ++e) { vp[e] = 0.f; gp[e] = 0.f; }
        } else {
            unpack8(*(const u32x4*)(pr - 4096 + 2048), vp); unpack8(*(const u32x4*)(pr - 4096 + 2048 + 8), vp + 8);
            unpack8(*(const u32x4*)(pr - 4096 + 3072), gp); unpack8(*(const u32x4*)(pr - 4096 + 3072 + 8), gp + 8);
        }
        float s = 0.f;
#pragma unroll
        for (int e = 0; e < 16; ++e) s += y[e];
        s += __shfl_xor(s, 1); s += __shfl_xor(s, 2);
        const float mean = s * (1.0f / 64.0f); float q = 0.f;
#pragma unroll
        for (int e = 0; e < 16; ++e) { y[e] -= mean; q += y[e] * y[e]; }
        q += __shfl_xor(q, 1); q += __shfl_xor(q, 2);
        const float rstd = 1.0f / sqrtf(q * (1.0f / 64.0f) + 64e-5f);
        const float bon = bonus[(size_t)m * 16 + (lane >> 2)];
        float o[16];
#pragma unroll
        for (int e = 0; e < 16; ++e) {
            const float vs = vc[e] + (vp[e] - vc[e]) * muv[e], gs = gc[e] + (gp[e] - gc[e]) * mug[e];
            const float yn = y[e] * rstd * lw[e] + lb[e] + bon * vs;
            o[e] = yn * gs * pg8::sigmoidf_(gs);
        }
        u32x4 w0, w1;
        w0.x = pk2(o[0], o[1]); w0.y = pk2(o[2], o[3]); w0.z = pk2(o[4], o[5]); w0.w = pk2(o[6], o[7]);
        w1.x = pk2(o[8], o[9]); w1.y = pk2(o[10], o[11]); w1.z = pk2(o[12], o[13]); w1.w = pk2(o[14], o[15]);
        *(u32x4*)(prw + (size_t)m * 4096 + 1024 + c0) = w0; *(u32x4*)(prw + (size_t)m * 4096 + 1024 + c0 + 8) = w1;
    }
}


#define XB_TMO      128
#define XB_XCNT(j)  (256  + 64 * (j))
#define XB_XSUB(j)  (1280 + 64 * (j))
#define XB_XGEN(j)  (2304 + 64 * (j))
#define XB_TOP      3328
#define XB_TOPGEN   3392
#define XCD_BAR_WORDS 3456
#define XB_SPIN_CAP (1u << 22)
__device__ __forceinline__ unsigned xb_ld(unsigned* p)              { return __hip_atomic_load(p, __ATOMIC_RELAXED, __HIP_MEMORY_SCOPE_AGENT); }
__device__ __forceinline__ unsigned xb_add(unsigned* p, unsigned v) { return __hip_atomic_fetch_add(p, v, __ATOMIC_RELAXED, __HIP_MEMORY_SCOPE_AGENT); }
__device__ __forceinline__ unsigned xb_xcc_id() { return (unsigned)__builtin_amdgcn_s_getreg((3 << 11) | 20) & 0xFu; }
#define XB_SPIN(cond, bar) do { unsigned _sp = 0; while (cond) { __builtin_amdgcn_s_sleep(1); \
    if ((++_sp & 255u) == 0u) { if (xb_ld(&(bar)[XB_TMO])) break; if (_sp > XB_SPIN_CAP) { atomicAdd(&(bar)[XB_TMO], 1u); break; } } } } while (0)
struct XcdBarrier { unsigned* bar; unsigned x; volatile LAS unsigned* st; };
__device__ __forceinline__ XcdBarrier xcd_barrier_post(unsigned* bar, volatile LAS unsigned* st) {
    XcdBarrier b; b.bar = bar; b.x = xb_xcc_id(); b.st = st;
    if (threadIdx.x == 0) (void)xb_add(&bar[XB_XCNT(b.x)], 1u);
    return b;
}
__device__ __forceinline__ void xcd_barrier_complete(unsigned* bar, unsigned x, unsigned& nloc, unsigned& nx) {
    const unsigned G = gridDim.x * gridDim.y * gridDim.z;
    unsigned sum, cnt, mine, sp = 0u;
    for (;;) {
        sum = 0u; cnt = 0u; mine = 0u;
#pragma unroll
        for (unsigned j = 0; j < 16; ++j) { const unsigned c = xb_ld(&bar[XB_XCNT(j)]); sum += c; cnt += (c > 0u) ? 1u : 0u; mine = (j == x) ? c : mine; }
        if (sum == G) break;
        __builtin_amdgcn_s_sleep(1);
        if ((++sp & 255u) == 0u) { if (xb_ld(&bar[XB_TMO])) break; if (sp > XB_SPIN_CAP) { atomicAdd(&bar[XB_TMO], 1u); break; } }
    }
    nloc = mine > 0u ? mine : 1u; nx = cnt > 0u ? cnt : 1u;
}
__device__ __forceinline__ void xcd_barrier(const XcdBarrier& b) {
    asm volatile("s_waitcnt vmcnt(0)" ::: "memory");
    __syncthreads();
    if (threadIdx.x == 0) {
        unsigned* bar = b.bar;
        __builtin_amdgcn_s_waitcnt(0);
        unsigned nloc = b.st[0], nx = b.st[1];
        if (nloc == 0u) { xcd_barrier_complete(bar, b.x, nloc, nx); b.st[0] = nloc; b.st[1] = nx; }
        const unsigned old = xb_add(&bar[XB_XSUB(b.x)], 1u);
        const unsigned gen = old / nloc;
        if (old + 1u == (gen + 1u) * nloc) {
            __builtin_amdgcn_fence(__ATOMIC_RELEASE, "agent");
            asm volatile("s_waitcnt vmcnt(0)" ::: "memory");
            const unsigned og = xb_add(&bar[XB_TOP], 1u);
            const unsigned tg = og / nx;
            if (og + 1u == (tg + 1u) * nx) xb_add(&bar[XB_TOPGEN], 1u);
            else XB_SPIN(xb_ld(&bar[XB_TOPGEN]) == tg, bar);
            __builtin_amdgcn_fence(__ATOMIC_ACQUIRE, "agent");
            xb_add(&bar[XB_XGEN(b.x)], 1u);
            asm volatile("s_waitcnt vmcnt(0)" ::: "memory");
        } else {
            XB_SPIN(xb_ld(&bar[XB_XGEN(b.x)]) == gen, bar);
            __builtin_amdgcn_fence(__ATOMIC_ACQUIRE, "agent");
            asm volatile("s_waitcnt vmcnt(0)" ::: "memory");
        }
    }
    __syncthreads();
}

constexpr int N_PHASES = 9;
__device__ __forceinline__ const Args* fresh_args() {
    auto p = __builtin_amdgcn_kernarg_segment_ptr(); asm volatile("" : "+s"(p)); return (const Args*)p;
}
__global__ void __launch_bounds__(NTHR, 2) fwd_kernel(Args a_in) {
    extern __shared__ __attribute__((aligned(16))) unsigned char lds_raw[];
    LAS unsigned char* lds = (LAS unsigned char*)lds_raw;
    const int tid = threadIdx.x, lane = tid & 63, wave = __builtin_amdgcn_readfirstlane(tid >> 6);
    const int G = gridDim.x;
    const int lo = a_in.ph_lo, hi = a_in.ph_hi, rep_mask = a_in.rep_mask;
#ifndef PH_MASK
#define PH_MASK 0x1ff
#endif
#define IN(k) (((PH_MASK >> (k)) & 1) && lo <= (k) && (k) < hi)
#define REP(k) for (int rep_ = 0; rep_ < 1 + ((rep_mask >> (k)) & 1); ++rep_)
#define SEAM(k) do { if (IN(k) && IN((k) + 1)) { xcd_barrier(xbar); } } while (0)
    volatile LAS unsigned* misc = (volatile LAS unsigned*)(lds + LDS_MISC);
    if (tid < 2) misc[tid] = 0u;
    __syncthreads();
    XcdBarrier xbar; xbar.bar = (unsigned*)(a_in.ws + WS_BAR); xbar.x = 0; xbar.st = misc;
    if (hi - lo > 1) xbar = xcd_barrier_post((unsigned*)(a_in.ws + WS_BAR), misc);
    if (hi > N_PHASES) cg::this_grid().sync();
    if (IN(0)) REP(0) { const Args a = *fresh_args(); unsigned char* ws = a.ws; (void)ws; p0_phase(a, lds, tid, lane, wave); }
    SEAM(0);
    if (IN(1)) REP(1) { const Args a = *fresh_args(); unsigned char* ws = a.ws; (void)ws; p1_phase(a, lds, tid, lane, wave); __syncthreads(); }
    SEAM(1);
    if (IN(2)) REP(2) { const Args a = *fresh_args(); unsigned char* ws = a.ws; (void)ws;
        pg8::Gemm g{(const bf16*)(ws + WS_H), (const bf16*)(ws + WS_WIN), M, NPAD, D, D}; pg8::StaticOrder S; S.init(M, NPAD, G, (int)blockIdx.x);
        pg8::EpiIn E{(bf16*)(ws + WS_PRW), (bf16*)(ws + WS_PAT), (bf16*)(ws + WS_PG), (bf16*)(ws + WS_PWA)};
        pg8::gemm_phase<pg8::EpiIn, pg8::StaticOrder, true>(lds, g, S, E);
    }
    SEAM(2);
    if (IN(3)) REP(3) { const Args a = *fresh_args(); unsigned char* ws = a.ws; (void)ws; p3_phase(a, lane, wave); }
    SEAM(3);
    if (IN(4)) { const Args a = *fresh_args(); unsigned char* ws = a.ws; (void)ws;
        int kl = 128; asm volatile("" : "+s"(kl));
        pg8::Gemm g{(const bf16*)(ws + WS_A2), (const bf16*)(ws + WS_WLORA), M, 2048, kl, 128}; pg8::StaticOrder S; S.init(M, 2048, G, (int)blockIdx.x);
        pg8::EpiLora E{(_Float16*)(ws + WS_WDEC), (_Float16*)(ws + WS_AA), a.w0, a.a0};
        const bool att_first = ((blockIdx.x >> 3) & 1) != 0;
        if (att_first) att::phase(a, lds, tid, lane, wave);
        __syncthreads();
        pg8::gemm_phase<pg8::EpiLora, pg8::StaticOrder, true>(lds, g, S, E);
        __syncthreads();
        if (!att_first) att::phase(a, lds, tid, lane, wave);
    }
    SEAM(4);
    if (IN(5)) REP(5) { const Args a = *fresh_args(); unsigned char* ws = a.ws; (void)ws; scan::phase(a, lds, tid, lane, wave); }
    SEAM(5);
    if (IN(6)) REP(6) { const Args a = *fresh_args(); unsigned char* ws = a.ws; (void)ws;
        const bool rows_first = ((blockIdx.x >> 3) & 1) == 0;
        if (rows_first) p6_phase(a, lane, wave);
        __syncthreads();
        pg8::Gemm g{(const bf16*)(ws + WS_PAT), (const bf16*)(ws + WS_WUPA), M, 2048, 1024, 2560}; pg8::StaticOrder S; S.init(M, 2048, G, (int)blockIdx.x);
        pg8::EpiUp<false> E{(bf16*)(ws + WS_MB), (const bf16*)(ws + WS_PG), 2048};
        pg8::gemm_phase<pg8::EpiUp<false>, pg8::StaticOrder, true>(lds, g, S, E);
        __syncthreads();
        if (!rows_first) p6_phase(a, lane, wave);
    }
    SEAM(6);
    if (IN(7)) { const Args a = *fresh_args(); unsigned char* ws = a.ws; (void)ws;
        pg8::Gemm g{(const bf16*)(ws + WS_PRW) + 1024, (const bf16*)(ws + WS_WUPR), M, 2048, 1024, 4096}; pg8::StaticOrder S; S.init(M, 2048, G, (int)blockIdx.x);
        pg8::EpiUp<true> E{(bf16*)(ws + WS_MB), (const bf16*)(ws + WS_PG), 0};
        pg8::gemm_phase<pg8::EpiUp<true>, pg8::StaticOrder, true>(lds, g, S, E);
    }
    SEAM(7);
    if (IN(8)) REP(8) { const Args a = *fresh_args(); unsigned char* ws = a.ws; (void)ws;
        pg8::Gemm g{(const bf16*)(ws + WS_MB), (const bf16*)(ws + WS_WO), M, 2048, 2048, 2048}; pg8::StaticOrder S; S.init(M, 2048, G, (int)blockIdx.x);
        pg8::EpiOut E{a.x, a.out, (const float*)(ws + WS_GATEF)};
        pg8::gemm_phase<pg8::EpiOut, pg8::StaticOrder, true>(lds, g, S, E);
    }
#undef IN
#undef SEAM
}

extern "C" void kernel_launch(void* const* d_in, const int* in_sizes, int n_in, void* d_out, int out_size, void* d_ws, size_t ws_size, hipStream_t stream) {
    static int grid = 0;
    if (grid == 0) {
        if (n_in != 22 || in_sizes[0] != M * D || out_size != M * D || ws_size < WS_END) { fprintf(stderr, "kernel_launch: unexpected shapes (n_in %d, in0 %d, out %d, ws %zu); nothing launched\n", n_in, n_in > 0 ? in_sizes[0] : -1, out_size, ws_size); grid = -1; return; }
        int dev = 0, cus = 0, per_cu = 0;
        if (hipGetDevice(&dev) != hipSuccess || hipDeviceGetAttribute(&cus, hipDeviceAttributeMultiprocessorCount, dev) != hipSuccess) { grid = -1; return; }
        if (hipFuncSetAttribute((const void*)fwd_kernel, hipFuncAttributeMaxDynamicSharedMemorySize, LDS_BYTES) != hipSuccess) { fprintf(stderr, "kernel_launch: hipFuncSetAttribute failed\n"); grid = -1; return; }
        if (hipOccupancyMaxActiveBlocksPerMultiprocessor(&per_cu, (const void*)fwd_kernel, NTHR, LDS_BYTES) != hipSuccess || per_cu < 1) { fprintf(stderr, "kernel_launch: occupancy query failed (%d)\n", per_cu); (void)hipGetLastError(); per_cu = 1; }
        grid = cus * 1;
        if (grid > cus * per_cu) grid = cus * per_cu;
    }
    if (grid < 0) return;
    Args a{};
    const float** ap = (const float**)&a;
    for (int i = 0; i < 22; ++i) ap[i] = (const float*)d_in[i];
    a.out = (float*)d_out; a.ws = (unsigned char*)d_ws; a.rep_mask = REP_MASK;
#if MK_SPLIT
    for (int p = 0; p < N_PHASES; ++p) { a.ph_lo = p; a.ph_hi = p + 1; hipLaunchKernelGGL(fwd_kernel, dim3(grid), dim3(NTHR), LDS_BYTES, stream, a); }
#else
    a.ph_lo = 0; a.ph_hi = N_PHASES;
    if (hipMemsetAsync((char*)d_ws + WS_BAR, 0, 16384, stream) != hipSuccess) { fprintf(stderr, "kernel_launch: memset of the barrier words failed\n"); return; }
    void* args[] = {&a};
    hipError_t e = hipLaunchCooperativeKernel((const void*)fwd_kernel, dim3(grid), dim3(NTHR), args, LDS_BYTES, stream);
    if (e != hipSuccess) fprintf(stderr, "cooperative launch failed: %s (grid %d)\n", hipGetErrorString(e), grid);
#endif
}
```

```cpp
#include <hip/hip_runtime.h>
#include <hip/hip_cooperative_groups.h>
#include <cstdio>
#include <cstdint>
namespace cg = cooperative_groups;

#define REP_MASK 0
#ifndef MK_SPLIT
#define MK_SPLIT 0
#endif

namespace pg8 {
#define PG8_LAS __attribute__((address_space(3)))
typedef unsigned short bf16_t;
typedef short bf16x8 __attribute__((ext_vector_type(8)));
typedef float f32x4 __attribute__((ext_vector_type(4)));
typedef unsigned u32x4 __attribute__((ext_vector_type(4)));
typedef unsigned u32x2 __attribute__((ext_vector_type(2)));
constexpr int BM = 256, BK = 64, HALF = 128, HTB = HALF * BK * 2, STAGE_BYTES = 8 * HTB, NXCD = 8, WGM = 8;

__host__ __device__ __forceinline__ int lds_byte(int r, int c) { const int st = (r >> 4) * 2 + (c >> 5), rr = r & 15, cc = c & 31, ob = rr * 64 + cc * 2; return st * 1024 + (ob ^ (((ob >> 9) & 1) << 5)); }
__host__ __device__ __forceinline__ void stage_rc(int b, int& R, int& C) { const int st = b / 1024, sb = b % 1024, swz = sb ^ (((sb >> 9) & 1) << 5); R = (st >> 1) * 16 + swz / 64; C = (st & 1) * 32 + (swz % 64) / 2; }
__host__ __device__ __forceinline__ int perm32(int rho) { const int n = rho >> 4, i = rho & 15; return 8 * (i >> 2) + 4 * n + (i & 3); }

struct Unit { int pm, pn; };
struct Gemm { const bf16_t* A; const bf16_t* Bt; int M, N, K, lda; };

struct StaticOrder {
    int nM, nN, nwg, G, c;
    __host__ __device__ void init(int M, int N, int G_, int c_) { nM = M / BM; nN = N / BM; nwg = nM * nN; G = G_; c = c_; }
    __host__ __device__ bool next(int i, Unit& u) const {
        const long L = (long)i * G + c; if (L >= nwg) return false;
        int wgid = (int)L; { const int q = nwg / NXCD, r = nwg % NXCD, xcd = wgid % NXCD, off = wgid / NXCD; wgid = (xcd < r ? xcd * (q + 1) : r * (q + 1) + (xcd - r) * q) + off; }
        const int nig = WGM * nN, gid = wgid / nig, fm = gid * WGM, gsz = (nM - fm) < WGM ? (nM - fm) : WGM;
        u.pm = fm + ((wgid % nig) % gsz); u.pn = (wgid % nig) / gsz; return true;
    }
};

__device__ __forceinline__ unsigned cvt_pk_bf16(float lo, float hi) { unsigned r; asm volatile("v_cvt_pk_bf16_f32 %0, %1, %2" : "=v"(r) : "v"(lo), "v"(hi)); return r; }
__device__ __forceinline__ float bflo(unsigned u) { return __uint_as_float(u << 16); }
__device__ __forceinline__ float bfhi(unsigned u) { return __uint_as_float(u & 0xffff0000u); }
__device__ __forceinline__ float sigmoidf_(float v) { return __builtin_amdgcn_rcpf(1.0f + __builtin_amdgcn_exp2f(-1.4426950408889634f * v)); }


struct EpiIn {
    static constexpr bool PERM = true;
    bf16_t *prw, *pat, *pg, *pwa;
    __device__ __forceinline__ void operator()(const f32x4 (&acc)[2][2][4][2], const Unit& u, int wr, int wc, int fr, int fq) const {
        bf16_t* base; int ldc; bool sig = false; const int pn = u.pn;
        if (pn < 16) { base = prw + pn * 256; ldc = 4096; }
        else if (pn < 26) { base = pat + (pn - 16) * 256; ldc = 2560; }
        else if (pn < 42) { base = pg + (pn - 26) * 256; ldc = 4096; sig = true; }
        else { base = pwa; ldc = 256; }
        const int row0 = u.pm * BM + wr * 64 + fr, col0 = wc * 32 + 8 * fq;
#pragma unroll
        for (int ai = 0; ai < 2; ++ai)
#pragma unroll
            for (int m = 0; m < 4; ++m) { bf16_t* rowp = base + (size_t)(row0 + ai * HALF + m * 16) * ldc + col0;
#pragma unroll
                for (int bj = 0; bj < 2; ++bj) { f32x4 v0 = acc[ai][bj][m][0], v1 = acc[ai][bj][m][1];
                    if (sig) {
#pragma unroll
                        for (int e = 0; e < 4; ++e) { v0[e] = sigmoidf_(v0[e]); v1[e] = sigmoidf_(v1[e]); } }
                    u32x4 w; w.x = cvt_pk_bf16(v0[0], v0[1]); w.y = cvt_pk_bf16(v0[2], v0[3]); w.z = cvt_pk_bf16(v1[0], v1[1]); w.w = cvt_pk_bf16(v1[2], v1[3]);
                    *(u32x4*)(rowp + bj * HALF) = w; } }
    }
};

typedef _Float16 h16x8 __attribute__((ext_vector_type(8)));
struct EpiLora {
    static constexpr bool PERM = true;
    _Float16 *wdec, *aa; const float *w0, *a0;
    __device__ __forceinline__ void operator()(const f32x4 (&acc)[2][2][4][2], const Unit& u, int wr, int wc, int fr, int fq) const {
        const bool isdec = u.pn < 4;
        _Float16* base = isdec ? wdec : aa; const float* bias = isdec ? w0 : a0;
        const int colt = (isdec ? u.pn : u.pn - 4) * 256;
        const int row0 = u.pm * BM + wr * 64 + fr, col0 = colt + wc * 32 + 8 * fq;
        f32x4 bv[2][2];
#pragma unroll
        for (int bj = 0; bj < 2; ++bj)
#pragma unroll
            for (int n = 0; n < 2; ++n) bv[bj][n] = *(const f32x4*)(bias + col0 + bj * HALF + 4 * n);
#pragma unroll
        for (int ai = 0; ai < 2; ++ai)
#pragma unroll
            for (int m = 0; m < 4; ++m) { _Float16* rowp = base + (size_t)(row0 + ai * HALF + m * 16) * 1024 + col0;
#pragma unroll
                for (int bj = 0; bj < 2; ++bj) {
                    const f32x4 v0 = acc[ai][bj][m][0] + bv[bj][0], v1 = acc[ai][bj][m][1] + bv[bj][1]; h16x8 o;
#pragma unroll
                    for (int e = 0; e < 8; ++e) { const float v = e < 4 ? v0[e & 3] : v1[e & 3];
                        float r = sigmoidf_(v);
                        if (isdec) r = __builtin_amdgcn_exp2f(-0.6065306597f * 1.4426950408889634f * r);
                        o[e] = (_Float16)r; }
                    *(h16x8*)(rowp + bj * HALF) = o; }
                if (m & 1) asm volatile("" ::: "memory"); }
    }
};

template <bool ADD> struct EpiUp {
    static constexpr bool PERM = true;
    bf16_t* mbuf; const bf16_t* pg; int goff;
    __device__ __forceinline__ void operator()(const f32x4 (&acc)[2][2][4][2], const Unit& u, int wr, int wc, int fr, int fq) const {
        const int row0 = u.pm * BM + wr * 64 + fr, col0 = u.pn * BM + wc * 32 + 8 * fq;
#pragma unroll
        for (int ai = 0; ai < 2; ++ai)
#pragma unroll
            for (int m = 0; m < 4; ++m) { const size_t row = (size_t)(row0 + ai * HALF + m * 16);
#pragma unroll
                for (int bj = 0; bj < 2; ++bj) { const int col = col0 + bj * HALF;
                    const u32x4 g = __builtin_nontemporal_load((const u32x4*)(pg + row * 4096 + goff + col));
                    f32x4 v0 = acc[ai][bj][m][0], v1 = acc[ai][bj][m][1];
                    v0[0] *= bflo(g.x); v0[1] *= bfhi(g.x); v0[2] *= bflo(g.y); v0[3] *= bfhi(g.y);
                    v1[0] *= bflo(g.z); v1[1] *= bfhi(g.z); v1[2] *= bflo(g.w); v1[3] *= bfhi(g.w);
                    if (ADD) { const u32x4 p = __builtin_nontemporal_load((const u32x4*)(mbuf + row * 2048 + col));
                        v0[0] += bflo(p.x); v0[1] += bfhi(p.x); v0[2] += bflo(p.y); v0[3] += bfhi(p.y);
                        v1[0] += bflo(p.z); v1[1] += bfhi(p.z); v1[2] += bflo(p.w); v1[3] += bfhi(p.w); }
                    u32x4 w; w.x = cvt_pk_bf16(v0[0], v0[1]); w.y = cvt_pk_bf16(v0[2], v0[3]); w.z = cvt_pk_bf16(v1[0], v1[1]); w.w = cvt_pk_bf16(v1[2], v1[3]);
                    *(u32x4*)(mbuf + row * 2048 + col) = w; } }
    }
};

struct EpiOut {
    static constexpr bool PERM = false;
    const float* x; float* out; const float* gatef;
    __device__ __forceinline__ void operator()(const f32x4 (&acc)[2][2][4][2], const Unit& u, int wr, int wc, int fr, int fq) const {
        const int row0 = u.pm * BM + wr * 64 + fr, col0 = u.pn * BM + wc * 32 + 4 * fq; const int b = u.pm >> 4;
        f32x4 gv[2][2];
#pragma unroll
        for (int bj = 0; bj < 2; ++bj)
#pragma unroll
            for (int n = 0; n < 2; ++n) gv[bj][n] = *(const f32x4*)(gatef + b * 2048 + col0 + bj * HALF + n * 16);
#pragma unroll
        for (int ai = 0; ai < 2; ++ai)
#pragma unroll
            for (int m = 0; m < 4; ++m) { const size_t off = (size_t)(row0 + ai * HALF + m * 16) * 2048 + col0;
#pragma unroll
                for (int bj = 0; bj < 2; ++bj)
#pragma unroll
                    for (int n = 0; n < 2; ++n) { const f32x4 xv = *(const f32x4*)(x + off + bj * HALF + n * 16);
                        *(f32x4*)(out + off + bj * HALF + n * 16) = xv + gv[bj][n] * acc[ai][bj][m][n]; }
                if (m & 1) asm volatile("" ::: "memory"); }
    }
};

template <class Epi, class Sched, bool ALIGN_EPI>
__device__ __forceinline__ void gemm_phase(PG8_LAS unsigned char* lds, const Gemm g, const Sched& S, const Epi& E) {
    const int tid = threadIdx.x, wid = __builtin_amdgcn_readfirstlane(tid >> 6), lane = tid & 63, wr = wid >> 2, wc = wid & 3, fr = lane & 15, fq = lane >> 4;
    const int K = g.K, nt = K / BK, lda = g.lda;
    unsigned voffA[2], voffB[2];
#pragma unroll
    for (int i = 0; i < 2; ++i) { int R, C; stage_rc(tid * 16 + i * 8192, R, C); const int Rb = Epi::PERM ? ((R & ~31) + perm32(R & 31)) : R;
        voffA[i] = (unsigned)(R * lda + C) * 2u; voffB[i] = (unsigned)(Rb * K + C) * 2u; }
    const size_t kstep = (size_t)(BK * 2);
    const size_t hstepA = (size_t)HALF * lda * 2, hstepB = (size_t)HALF * K * 2;
    const size_t tstepA = 2 * hstepA, tstepB = 2 * hstepB;
    const unsigned ldsw = (unsigned)wid * 1024u;
    const int aoff = lds_byte(wr * 64 + fr, fq * 8), boff = lds_byte(wc * 32 + fr, fq * 8);
#define PG8_SA(b, h) (((b) * 2 + (h)) * HTB)
#define PG8_SB(b, h) ((4 + (b) * 2 + (h)) * HTB)
#define PG8_STAGE(bufoff, gbase, voff) do { _Pragma("unroll") for (int _i = 0; _i < 2; ++_i) \
        __builtin_amdgcn_global_load_lds((const unsigned*)((const char*)(gbase) + (voff)[_i]), (PG8_LAS unsigned*)(lds + (bufoff) + ldsw + _i * 8192), 16, 0, 0); } while (0)
#define PG8_LDA(dst, b, h) do { _Pragma("unroll") for (int m = 0; m < 4; ++m) _Pragma("unroll") for (int k = 0; k < 2; ++k) dst[m][k] = *(const PG8_LAS bf16x8*)(lds + PG8_SA(b, h) + aoff + m * 2048 + k * 1024); } while (0)
#define PG8_LDB(dst, b, h) do { _Pragma("unroll") for (int n = 0; n < 2; ++n) _Pragma("unroll") for (int k = 0; k < 2; ++k) dst[n][k] = *(const PG8_LAS bf16x8*)(lds + PG8_SB(b, h) + boff + n * 2048 + k * 1024); } while (0)
#define PG8_MMA(ai, bj, At, Bt) do { __builtin_amdgcn_s_setprio(1); _Pragma("unroll") for (int m = 0; m < 4; ++m) _Pragma("unroll") for (int n = 0; n < 2; ++n) _Pragma("unroll") for (int k = 0; k < 2; ++k) \
        acc[ai][bj][m][n] = __builtin_amdgcn_mfma_f32_16x16x32_bf16(Bt[n][k], At[m][k], acc[ai][bj][m][n], 0, 0, 0); __builtin_amdgcn_s_setprio(0); } while (0)
#define PG8_WAIT_V(n) asm volatile("s_waitcnt vmcnt(" #n ")" ::: "memory")
#define PG8_WAIT_L(n) asm volatile("s_waitcnt lgkmcnt(" #n ")" ::: "memory")
#define PG8_BAR __builtin_amdgcn_s_barrier()
#define PG8_SCHED __builtin_amdgcn_sched_barrier(0)
    Unit cur, nxt; int ui = 0;
    if (!S.next(0, cur)) return;
    f32x4 acc[2][2][4][2];
#pragma unroll
    for (int a = 0; a < 2; ++a)
#pragma unroll
        for (int b = 0; b < 2; ++b)
#pragma unroll
            for (int m = 0; m < 4; ++m)
#pragma unroll
                for (int n = 0; n < 2; ++n) acc[a][b][m][n] = (f32x4){0.f, 0.f, 0.f, 0.f};
    bf16x8 At[4][2], B0[2][2], B1[2][2];
    const char* cA = (const char*)g.A + (size_t)cur.pm * tstepA; const char* cB = (const char*)g.Bt + (size_t)cur.pn * tstepB;
    PG8_STAGE(PG8_SB(0, 0), cB, voffB); PG8_STAGE(PG8_SB(0, 1), cB + hstepB, voffB); PG8_STAGE(PG8_SA(0, 0), cA, voffA); PG8_STAGE(PG8_SA(0, 1), cA + hstepA, voffA);
    if (wr == 1) PG8_BAR;
    PG8_WAIT_V(2); PG8_BAR;
    PG8_STAGE(PG8_SB(1, 0), cB + kstep, voffB); PG8_STAGE(PG8_SA(1, 0), cA + kstep, voffA); PG8_STAGE(PG8_SB(1, 1), cB + hstepB + kstep, voffB);
    PG8_WAIT_V(6); PG8_BAR;
    for (;;) {
        const bool has_next = S.next(ui + 1, nxt);
        const char* nA = has_next ? (const char*)g.A + (size_t)nxt.pm * tstepA : cA; const char* nB = has_next ? (const char*)g.Bt + (size_t)nxt.pn * tstepB : cB;
        for (int t = 0; t < nt; t += 2) {
            const bool last = (t == nt - 2);
            const char* a1 = cA + (size_t)(t + 1) * kstep;
            const char* a2 = last ? nA : cA + (size_t)(t + 2) * kstep; const char* b2 = last ? nB : cB + (size_t)(t + 2) * kstep;
            const char* a3 = a2 + kstep; const char* b3 = b2 + kstep;
            PG8_LDB(B0, 0, 0); PG8_LDB(B1, 0, 1); PG8_SCHED; PG8_LDA(At, 0, 0); PG8_STAGE(PG8_SA(1, 1), a1 + hstepA, voffA);
            PG8_WAIT_V(8); PG8_WAIT_L(0); PG8_BAR; PG8_MMA(0, 0, At, B0); PG8_MMA(0, 1, At, B1); PG8_BAR; PG8_SCHED;
            PG8_LDA(At, 0, 1); PG8_STAGE(PG8_SB(0, 0), b2, voffB); PG8_STAGE(PG8_SB(0, 1), b2 + hstepB, voffB); PG8_STAGE(PG8_SA(0, 0), a2, voffA);
            PG8_WAIT_V(8); PG8_WAIT_L(0); PG8_BAR; PG8_MMA(1, 0, At, B0); PG8_MMA(1, 1, At, B1); PG8_BAR; PG8_SCHED;
            PG8_LDB(B0, 1, 0); PG8_LDB(B1, 1, 1); PG8_SCHED; PG8_LDA(At, 1, 0); PG8_STAGE(PG8_SA(0, 1), a2 + hstepA, voffA);
            PG8_WAIT_V(8); PG8_WAIT_L(0); PG8_BAR; PG8_MMA(0, 0, At, B0); PG8_MMA(0, 1, At, B1); PG8_BAR; PG8_SCHED;
            PG8_LDA(At, 1, 1); PG8_STAGE(PG8_SB(1, 0), b3, voffB); PG8_STAGE(PG8_SB(1, 1), b3 + hstepB, voffB); PG8_STAGE(PG8_SA(1, 0), a3, voffA);
            PG8_WAIT_V(8); PG8_WAIT_L(0); PG8_BAR; PG8_MMA(1, 0, At, B0); PG8_MMA(1, 1, At, B1); PG8_BAR; PG8_SCHED;
        }
        if constexpr (ALIGN_EPI) { if (wr == 0) PG8_BAR; }
        E(acc, cur, wr, wc, fr, fq);
        if (!has_next) break;
#pragma unroll
        for (int a = 0; a < 2; ++a)
#pragma unroll
            for (int b = 0; b < 2; ++b)
#pragma unroll
                for (int m = 0; m < 4; ++m)
#pragma unroll
                    for (int n = 0; n < 2; ++n) acc[a][b][m][n] = (f32x4){0.f, 0.f, 0.f, 0.f};
        cur = nxt; cA = nA; cB = nB; ++ui;
        if constexpr (ALIGN_EPI) { if (wr == 1) PG8_BAR; }
    }
    PG8_WAIT_V(0);
    if constexpr (!ALIGN_EPI) { if (wr == 0) PG8_BAR; }
    PG8_BAR;
#undef PG8_SA
#undef PG8_SB
#undef PG8_STAGE
#undef PG8_LDA
#undef PG8_LDB
#undef PG8_MMA
#undef PG8_WAIT_V
#undef PG8_WAIT_L
#undef PG8_BAR
#undef PG8_SCHED
}
}

#define LAS __attribute__((address_space(3)))
typedef unsigned short bf16;
typedef float f32x4 __attribute__((ext_vector_type(4)));
typedef float f32x16 __attribute__((ext_vector_type(16)));
typedef unsigned u32x4 __attribute__((ext_vector_type(4)));
typedef unsigned u32x2 __attribute__((ext_vector_type(2)));
typedef short bf16x8 __attribute__((ext_vector_type(8)));
typedef _Float16 h16x4 __attribute__((ext_vector_type(4)));
typedef _Float16 h16x8 __attribute__((ext_vector_type(8)));

constexpr int NWAVES = 8, NTHR = 512;
constexpr int D = 2048, BATCH = 4, SEQ = 4096, M = BATCH * SEQ;
constexpr int RW = 1024, RW_COLS = 4224, AT_COLS = 2560, IN_COLS = 10880, NPAD = 11008;
constexpr size_t MiB = 1u << 20;
constexpr size_t WS_MODP = 0;
constexpr size_t WS_GATEF = 1 * MiB + MiB / 2;
constexpr size_t WS_BAR = 1 * MiB + MiB / 2 + 65536;
constexpr size_t WS_BONUS = 2 * MiB;
constexpr size_t WS_WLORA = 3 * MiB;
constexpr size_t WS_WUPR = 4 * MiB, WS_WUPA = 8 * MiB, WS_WO = 12 * MiB;
constexpr size_t WS_PRW = 20 * MiB;
constexpr size_t WS_PAT = 148 * MiB;
constexpr size_t WS_PG = 228 * MiB;
constexpr size_t WS_PWA = 356 * MiB;
constexpr size_t WS_H = 364 * MiB;
constexpr size_t WS_WIN = 428 * MiB;
constexpr size_t WS_A2 = 364 * MiB;
constexpr size_t WS_WDEC = 368 * MiB, WS_KK = 400 * MiB, WS_AA = 432 * MiB;
constexpr size_t WS_YRAW = 464 * MiB;
constexpr size_t WS_MB = 368 * MiB;
constexpr size_t WS_END = 512 * MiB;
constexpr int LDS_BYTES = 147456;
constexpr int LDS_MISC = 147200;

struct Args {
    const float *x, *c, *ada_w, *ada_b, *norm_g, *w_in, *mu, *w0, *w2, *a0, *a2, *k_k, *k_a, *r_k, *lnx_w, *lnx_b, *q_norm, *k_norm, *sinks, *w_up_r, *w_up_a, *w_o;
    float* out; unsigned char* ws; int ph_lo, ph_hi, rep_mask, pad;
};

__device__ __forceinline__ unsigned f2bf(float f) { unsigned u = __builtin_bit_cast(unsigned, f); return (u + 0x7fffu + ((u >> 16) & 1u)) >> 16; }
__device__ __forceinline__ unsigned pk2(float lo, float hi) { return pg8::cvt_pk_bf16(lo, hi); }
__device__ __forceinline__ float bflo(unsigned u) { return __uint_as_float(u << 16); }
__device__ __forceinline__ float bfhi(unsigned u) { return __uint_as_float(u & 0xffff0000u); }
__device__ __forceinline__ float wave_sum(float v) {
#pragma unroll
    for (int o = 1; o < 64; o <<= 1) v += __shfl_xor(v, o);
    return v;
}
template <int CTRL> __device__ __forceinline__ float dpp_f(float x) { return __int_as_float(__builtin_amdgcn_update_dpp(0, __float_as_int(x), CTRL, 0xf, 0xf, false)); }
__device__ __forceinline__ float row16_sum(float x) {
    x += dpp_f<0x128>(x); x += dpp_f<0x124>(x); x += dpp_f<0x122>(x); x += dpp_f<0x121>(x); return x;
}
__device__ __forceinline__ void unpack8(const u32x4 v, float* f) { f[0] = bflo(v.x); f[1] = bfhi(v.x); f[2] = bflo(v.y); f[3] = bfhi(v.y); f[4] = bflo(v.z); f[5] = bfhi(v.z); f[6] = bflo(v.w); f[7] = bfhi(v.w); }

__device__ __forceinline__ void p0_transpose_item(const float* W, int Nsrc, int sc0, int k0, bf16* WT, int Kdst, int dr0, bool zero, LAS float* scr, int lane) {
    if (!zero) {
#pragma unroll 8
        for (int i = 0; i < 32; ++i) { const int kk = 2 * i + (lane >> 5); scr[kk * 33 + (lane & 31)] = __builtin_nontemporal_load(W + (size_t)(k0 + kk) * Nsrc + sc0 + (lane & 31)); }
    }
    asm volatile("s_waitcnt lgkmcnt(0)" ::: "memory");
    const int c = lane & 7;
#pragma unroll
    for (int j = 0; j < 4; ++j) { const int n = (lane >> 3) + 8 * j; const LAS float* s = scr + (8 * c) * 33 + n;
        u32x4 o;
        if (zero) { o = (u32x4){0u, 0u, 0u, 0u}; }
        else { o.x = pk2(s[0 * 33], s[1 * 33]); o.y = pk2(s[2 * 33], s[3 * 33]); o.z = pk2(s[4 * 33], s[5 * 33]); o.w = pk2(s[6 * 33], s[7 * 33]); }
        *(u32x4*)(WT + (size_t)(dr0 + n) * Kdst + k0 + 8 * c) = o; }
    asm volatile("s_waitcnt lgkmcnt(0)" ::: "memory");
}
__device__ __forceinline__ int win_src_col(int n0) {
    if (n0 < 4096) return n0;
    if (n0 < 6656) return 4224 + (n0 - 4096);
    if (n0 < 10752) return 6784 + (n0 - 6656);
    return 4096 + (n0 - 10752);
}
__device__ __forceinline__ void p0_phase(const Args& a, LAS unsigned char* lds, int tid, int lane, int wave) {
    unsigned char* ws = a.ws;
    const int gw = blockIdx.x * NWAVES + wave, NGW = gridDim.x * NWAVES;
    for (int task = wave * (int)gridDim.x + (int)blockIdx.x; task < 16 * 24; task += NGW) {
        const int kc = task / 24, cgp = task % 24, col = cgp * 256 + lane * 4;
        f32x4 acc[4]; float c0[4], c1[4];
#pragma unroll
        for (int b = 0; b < 4; ++b) { acc[b] = (f32x4){0.f, 0.f, 0.f, 0.f}; c0[b] = a.c[b * 2048 + kc * 128 + lane]; c1[b] = a.c[b * 2048 + kc * 128 + 64 + lane]; }
        const float* wp = a.ada_w + (size_t)(kc * 128) * 6144 + col;
#pragma unroll 8
        for (int k = 0; k < 64; ++k) { const f32x4 w = __builtin_nontemporal_load((const f32x4*)(wp + (size_t)k * 6144));
#pragma unroll
            for (int b = 0; b < 4; ++b) acc[b] += w * __builtin_bit_cast(float, __builtin_amdgcn_readlane(__builtin_bit_cast(int, c0[b]), k)); }
#pragma unroll 8
        for (int k = 0; k < 64; ++k) { const f32x4 w = __builtin_nontemporal_load((const f32x4*)(wp + (size_t)(64 + k) * 6144));
#pragma unroll
            for (int b = 0; b < 4; ++b) acc[b] += w * __builtin_bit_cast(float, __builtin_amdgcn_readlane(__builtin_bit_cast(int, c1[b]), k)); }
        float* mp = (float*)(ws + WS_MODP) + (size_t)kc * 4 * 6144 + col;
#pragma unroll
        for (int b = 0; b < 4; ++b) *(f32x4*)(mp + b * 6144) = acc[b];
    }
    LAS float* scr = (LAS float*)(lds + wave * 16384);
    constexpr int I_IN = 32 * (NPAD / 32), I_UP = 16 * 64, I_O = 32 * 64, NITEMS = I_IN + 2 * I_UP + I_O;
    for (int it = (wave - 2) * (int)gridDim.x + (int)blockIdx.x; wave >= 2 && it < NITEMS; it += 6 * (int)gridDim.x) {
        int r = it;
        if (r < I_IN) { const int nblk = NPAD / 32, kb = r / nblk, nb = r % nblk, n0 = nb * 32; const bool z = n0 >= IN_COLS;
            p0_transpose_item(a.w_in, IN_COLS, z ? 0 : win_src_col(n0), kb * 64, (bf16*)(ws + WS_WIN), 2048, n0, z, scr, lane); continue; }
        r -= I_IN;
        if (r < I_UP) { const int kb = r / 64, nb = r % 64; p0_transpose_item(a.w_up_r, 2048, nb * 32, kb * 64, (bf16*)(ws + WS_WUPR), 1024, nb * 32, false, scr, lane); continue; }
        r -= I_UP;
        if (r < I_UP) { const int kb = r / 64, nb = r % 64; p0_transpose_item(a.w_up_a, 2048, nb * 32, kb * 64, (bf16*)(ws + WS_WUPA), 1024, nb * 32, false, scr, lane); continue; }
        r -= I_UP;
        { const int kb = r / 64, nb = r % 64; p0_transpose_item(a.w_o, 2048, nb * 32, kb * 64, (bf16*)(ws + WS_WO), 2048, nb * 32, false, scr, lane); }
    }
    bf16* wl = (bf16*)(ws + WS_WLORA);
    for (int idx = blockIdx.x * NTHR + tid; idx < 2048 * 128; idx += gridDim.x * NTHR) {
        const int n = idx >> 7, k = idx & 127; float v = 0.f;
        if (n < 1024) { if (k < 64) v = a.w2[k * 1024 + n]; } else { if (k >= 64) v = a.a2[(k - 64) * 1024 + (n - 1024)]; }
        wl[idx] = (bf16)f2bf(v);
    }
}

__device__ __forceinline__ void p1_phase(const Args& a, LAS unsigned char* lds, int tid, int lane, int wave) {
    unsigned char* ws = a.ws;
    LAS float* mul = (LAS float*)lds; LAS float* add = mul + 2048;
    const float* modp = (const float*)(ws + WS_MODP);
    if (blockIdx.x < 4) {
        const int b = blockIdx.x, col = tid * 4; f32x4 s = *(const f32x4*)(a.ada_b + 4096 + col);
        for (int kc = 0; kc < 16; ++kc) s += *(const f32x4*)(modp + ((size_t)kc * 4 + b) * 6144 + 4096 + col);
        *(f32x4*)((float*)(ws + WS_GATEF) + b * 2048 + col) = s;
    }
    for (int rb = blockIdx.x; rb < M / 64; rb += gridDim.x) {
        const int b = rb / 64;
        __syncthreads();
        { const int col = tid * 4; f32x4 sh = *(const f32x4*)(a.ada_b + col), sc = *(const f32x4*)(a.ada_b + 2048 + col);
            for (int kc = 0; kc < 16; ++kc) { const float* p = modp + ((size_t)kc * 4 + b) * 6144; sh += *(const f32x4*)(p + col); sc += *(const f32x4*)(p + 2048 + col); }
            const f32x4 g = *(const f32x4*)(a.norm_g + col);
#pragma unroll
            for (int e = 0; e < 4; ++e) { mul[col + e] = g[e] * (1.0f + sc[e]); add[col + e] = sh[e]; } }
        __syncthreads();
        for (int i = 0; i < 8; ++i) {
            const int m = rb * 64 + wave * 8 + i;
            const f32x4* xr = (const f32x4*)(a.x + (size_t)m * D) + lane;
            f32x4 v[8]; float s = 0.f;
#pragma unroll
            for (int j = 0; j < 8; ++j) { v[j] = __builtin_nontemporal_load(xr + 64 * j); s += (v[j].x * v[j].x + v[j].y * v[j].y) + (v[j].z * v[j].z + v[j].w * v[j].w); }
            const float rstd = 1.0f / sqrtf(wave_sum(s) * (1.0f / D) + 1e-6f);
            unsigned long long* o8 = (unsigned long long*)((bf16*)(ws + WS_H) + (size_t)m * D) + lane;
#pragma unroll
            for (int j = 0; j < 8; ++j) { const int col = 4 * lane + 256 * j;
                const float h0 = v[j].x * rstd * mul[col] + add[col], h1 = v[j].y * rstd * mul[col + 1] + add[col + 1], h2 = v[j].z * rstd * mul[col + 2] + add[col + 2], h3 = v[j].w * rstd * mul[col + 3] + add[col + 3];
                o8[64 * j] = (unsigned long long)pk2(h0, h1) | ((unsigned long long)pk2(h2, h3) << 32); }
        }
    }
}

__device__ __forceinline__ void p3_phase(const Args& a, int lane, int wave) {
    unsigned char* ws = a.ws;
    const bf16* pwa = (const bf16*)(ws + WS_PWA);
    bf16* a2 = (bf16*)(ws + WS_A2);
    const int gw = blockIdx.x * NWAVES + wave, NGW = gridDim.x * NWAVES;
    const float muw0 = a.mu[4096 + 2 * lane], muw1 = a.mu[4096 + 2 * lane + 1];
    for (int m = gw; m < M; m += NGW) {
        const bool first = (m % SEQ) == 0;
        const unsigned wc = *(const unsigned*)(pwa + (size_t)m * 256 + 2 * lane);
        const unsigned wp = first ? 0u : *(const unsigned*)(pwa + (size_t)(m - 1) * 256 + 2 * lane);
        float v0 = bflo(wc), v1 = bfhi(wc);
        v0 += (bflo(wp) - v0) * muw0; v1 += (bfhi(wp) - v1) * muw1;
        if (lane < 32) { v0 = tanhf(v0); v1 = tanhf(v1); }
        *(unsigned*)(a2 + (size_t)m * 128 + 2 * lane) = pk2(v0, v1);
    }
}

namespace att {
constexpr int KP = 72, VP = 260, SP = 72;
constexpr int LDS_K = 0, LDS_V = 256 * KP * 2, LDS_S = LDS_V + 64 * VP * 2, LDS_TOTAL = LDS_S + 8 * 32 * SP * 2;
__device__ __forceinline__ int crow(int r, int hi) { return (r & 3) + 8 * (r >> 2) + 4 * hi; }
__device__ __forceinline__ void phase(const Args& a, LAS unsigned char* lds, int tid, int lane, int wave) {
    unsigned char* ws = a.ws;
    bf16* pat = (bf16*)(ws + WS_PAT);
    const int r32 = lane & 31, hi = lane >> 5;
    const int ch = tid & 7;
    float knw[8], qnw[8];
#pragma unroll
    for (int e = 0; e < 8; ++e) { knw[e] = a.k_norm[8 * ch + e]; qnw[e] = a.q_norm[8 * ch + e] * 0.125f; }
    LAS unsigned char* stg = lds + LDS_S + wave * (32 * SP * 2);
    for (int unit = blockIdx.x; unit < 512; unit += gridDim.x) {
        const int b = unit >> 7, kh = (unit >> 5) & 3, n = unit & 31;
        const int m0 = b * SEQ + n * 128;
        __syncthreads();
#pragma unroll
        for (int i = 0; i < 4; ++i) {
            const int s = (tid >> 3) + 64 * i; const bool valid = (n > 0) || (s >= 128);
            const bf16* src = pat + (size_t)(m0 - 128 + s) * 2560 + 2048 + kh * 64 + 8 * ch;
            float kf[8], vf[8];
            if (valid) { unpack8(__builtin_nontemporal_load((const u32x4*)src), kf); unpack8(__builtin_nontemporal_load((const u32x4*)(src + 256)), vf); }
            else {
#pragma unroll
                for (int e = 0; e < 8; ++e) { kf[e] = 0.f; vf[e] = 0.f; }
            }
            float ss = 0.f;
#pragma unroll
            for (int e = 0; e < 8; ++e) ss += kf[e] * kf[e];
            ss += __shfl_xor(ss, 1); ss += __shfl_xor(ss, 2); ss += __shfl_xor(ss, 4);
            const float rstd = 1.0f / sqrtf(ss * (1.0f / 64.0f) + 1e-6f);
            u32x4 w;
            w.x = pk2(kf[0] * rstd * knw[0], kf[1] * rstd * knw[1]); w.y = pk2(kf[2] * rstd * knw[2], kf[3] * rstd * knw[3]);
            w.z = pk2(kf[4] * rstd * knw[4], kf[5] * rstd * knw[5]); w.w = pk2(kf[6] * rstd * knw[6], kf[7] * rstd * knw[7]);
            *(LAS u32x4*)(lds + LDS_K + (s * KP + 8 * ch) * 2) = w;
            LAS bf16* vt = (LAS bf16*)(lds + LDS_V);
#pragma unroll
            for (int e = 0; e < 8; ++e) vt[(8 * ch + e) * VP + s] = (bf16)f2bf(vf[e]);
        }
        __syncthreads();
#pragma unroll 1
        for (int it = 0; it < 2; ++it) {
            const int task = wave + 8 * it, g = task >> 2, qq = task & 3, hq = kh * 4 + g;
            bf16* qbase = pat + (size_t)(m0 + 32 * qq) * 2560 + hq * 64;
#pragma unroll
            for (int i = 0; i < 4; ++i) { const int row = (lane >> 3) + 8 * i; float qv[8];
                unpack8(__builtin_nontemporal_load((const u32x4*)(qbase + (size_t)row * 2560 + 8 * ch)), qv);
                u32x4 w; w.x = pk2(qv[0] * qnw[0], qv[1] * qnw[1]); w.y = pk2(qv[2] * qnw[2], qv[3] * qnw[3]); w.z = pk2(qv[4] * qnw[4], qv[5] * qnw[5]); w.w = pk2(qv[6] * qnw[6], qv[7] * qnw[7]);
                float s2 = 0.f;
#pragma unroll
                for (int e = 0; e < 8; ++e) s2 += qv[e] * qv[e];
                s2 += __shfl_xor(s2, 1); s2 += __shfl_xor(s2, 2); s2 += __shfl_xor(s2, 4);
                *(LAS u32x4*)(stg + (row * SP + 8 * ch) * 2) = w;
                if (ch == 0) *(LAS float*)(stg + (row * SP + 64) * 2) = 1.0f / sqrtf(s2 * (1.0f / 64.0f) + 1e-6f);
            }
            asm volatile("s_waitcnt lgkmcnt(0)" ::: "memory");
            bf16x8 qb[4];
#pragma unroll
            for (int ks = 0; ks < 4; ++ks) qb[ks] = *(const LAS bf16x8*)(stg + (r32 * SP + 16 * ks + 8 * hi) * 2);
            const float qrs = *(const LAS float*)(stg + (r32 * SP + 64) * 2);
            f32x16 sc[5];
#pragma unroll
            for (int kt = 0; kt < 5; ++kt) {
#pragma unroll
                for (int r = 0; r < 16; ++r) sc[kt][r] = 0.f;
                const LAS unsigned char* kb = lds + LDS_K + ((32 * (qq + kt) + r32) * KP + 8 * hi) * 2;
#pragma unroll
                for (int ks = 0; ks < 4; ++ks) { const bf16x8 kfr = *(const LAS bf16x8*)(kb + 32 * ks);
                    sc[kt] = __builtin_amdgcn_mfma_f32_32x32x16_bf16(kfr, qb[ks], sc[kt], 0, 0, 0); }
            }
            const float sink = a.sinks[hq];
            float mx = sink;
#pragma unroll
            for (int kt = 0; kt < 5; ++kt)
#pragma unroll
                for (int r = 0; r < 16; ++r) { const int s = 32 * (qq + kt) + crow(r, hi); const int diff = 32 * qq + r32 + 128 - s;
                    const bool ok = (diff >= 0) && (diff < 128) && ((n > 0) || (s >= 128));
                    sc[kt][r] = ok ? sc[kt][r] * qrs : -1e30f; mx = fmaxf(mx, sc[kt][r]); }
            mx = fmaxf(mx, __shfl_xor(mx, 32));
            float l = 0.f;
#pragma unroll
            for (int kt = 0; kt < 5; ++kt)
#pragma unroll
                for (int r = 0; r < 16; ++r) { const float p = __expf(sc[kt][r] - mx); sc[kt][r] = p; l += p; }
            l += __shfl_xor(l, 32);
            l += __expf(sink - mx);
            f32x16 o[2];
#pragma unroll
            for (int dt = 0; dt < 2; ++dt)
#pragma unroll
                for (int r = 0; r < 16; ++r) o[dt][r] = 0.f;
#pragma unroll
            for (int kt = 0; kt < 5; ++kt)
#pragma unroll
                for (int s2 = 0; s2 < 2; ++s2) {
                    u32x4 pw; pw.x = pk2(sc[kt][8 * s2 + 0], sc[kt][8 * s2 + 1]); pw.y = pk2(sc[kt][8 * s2 + 2], sc[kt][8 * s2 + 3]);
                    pw.z = pk2(sc[kt][8 * s2 + 4], sc[kt][8 * s2 + 5]); pw.w = pk2(sc[kt][8 * s2 + 6], sc[kt][8 * s2 + 7]);
                    const bf16x8 pf = __builtin_bit_cast(bf16x8, pw);
                    const int keyb = 32 * (qq + kt) + 16 * s2 + 4 * hi;
#pragma unroll
                    for (int dt = 0; dt < 2; ++dt) {
                        const LAS unsigned char* vb = lds + LDS_V + ((32 * dt + r32) * VP + keyb) * 2;
                        const u32x2 lo = *(const LAS u32x2*)vb, hh = *(const LAS u32x2*)(vb + 16);
                        const u32x4 vv = (u32x4){lo.x, lo.y, hh.x, hh.y};
                        o[dt] = __builtin_amdgcn_mfma_f32_32x32x16_bf16(__builtin_bit_cast(bf16x8, vv), pf, o[dt], 0, 0, 0); }
                }
            const float rl = 1.0f / l;
#pragma unroll
            for (int dt = 0; dt < 2; ++dt)
#pragma unroll
                for (int g4 = 0; g4 < 4; ++g4) { const int d0 = 32 * dt + 8 * g4 + 4 * hi;
                    u32x2 w; w.x = pk2(o[dt][4 * g4 + 0] * rl, o[dt][4 * g4 + 1] * rl); w.y = pk2(o[dt][4 * g4 + 2] * rl, o[dt][4 * g4 + 3] * rl);
                    *(LAS u32x2*)(stg + (r32 * SP + d0) * 2) = w; }
            asm volatile("s_waitcnt lgkmcnt(0)" ::: "memory");
#pragma unroll
            for (int i = 0; i < 4; ++i) { const int row = (lane >> 3) + 8 * i; float ov[8], gv[8];
                bf16* rp = qbase + (size_t)row * 2560 + 8 * ch;
                unpack8(*(const LAS u32x4*)(stg + (row * SP + 8 * ch) * 2), ov); unpack8(__builtin_nontemporal_load((const u32x4*)(rp + 1024)), gv);
#pragma unroll
                for (int e = 0; e < 8; ++e) ov[e] = ov[e] * gv[e] * pg8::sigmoidf_(gv[e]);
                u32x4 w; w.x = pk2(ov[0], ov[1]); w.y = pk2(ov[2], ov[3]); w.z = pk2(ov[4], ov[5]); w.w = pk2(ov[6], ov[7]);
                *(u32x4*)rp = w; }
            asm volatile("s_waitcnt lgkmcnt(0)" ::: "memory");
        }
    }
    __syncthreads();
}
}

namespace scan {
constexpr int TT = 32, NT = SEQ / TT;
constexpr int OFF_R = 0, OFF_W = 2048, OFF_K = 4096, OFF_A = 6144, OFF_B = 8192, OFF_V = 10240, OFF_Y = 10752, BUF_F = 12800;
typedef float lf4 __attribute__((ext_vector_type(4)));
typedef float lf2 __attribute__((ext_vector_type(2)));

struct StageCtx { const bf16* prw; const _Float16 *aab, *wdb; float* bonus; bf16* yraw; int b, hh, quarter; float mur[4], muk[4], muv[4], ka[4], rk[4], kkw[4]; };
struct Raw { u32x2 r0, k0, v0, r1, k1, v1; h16x4 aa, wd; };
struct Ops { lf4 a, b, w, k, r; float v; };

__device__ __forceinline__ void stage_load(const StageCtx& c, int tau, int ht, Raw (&raw)[2]) {
#pragma unroll
    for (int i = 0; i < 2; ++i) {
        const int idx = ht + 256 * i, t = idx >> 4, c4 = (idx & 15) * 4, tt = tau * TT + t;
        const size_t m = (size_t)c.b * SEQ + tt; const int ch = c.hh * 64 + c4;
        const bf16* p = c.prw + m * 4096 + ch;
        raw[i].r0 = *(const u32x2*)p; raw[i].k0 = *(const u32x2*)(p + 1024); raw[i].v0 = *(const u32x2*)(p + 2048);
        const bf16* pp = (tt > 0) ? p - 4096 : p;
        raw[i].r1 = *(const u32x2*)pp; raw[i].k1 = *(const u32x2*)(pp + 1024); raw[i].v1 = *(const u32x2*)(pp + 2048);
        raw[i].aa = *(const h16x4*)(c.aab + m * 1024 + ch); raw[i].wd = *(const h16x4*)(c.wdb + m * 1024 + ch);
    }
}
__device__ __forceinline__ void stage_conv(const StageCtx& c, int tau, LAS float* buf, int ht, const Raw (&raw)[2]) {
#pragma unroll
    for (int i = 0; i < 2; ++i) {
        const int idx = ht + 256 * i, t = idx >> 4, c4 = (idx & 15) * 4, tt = tau * TT + t;
        const size_t m = (size_t)c.b * SEQ + tt;
        const float pz = (tt > 0) ? 1.0f : 0.0f;
        const u32x2 r0 = raw[i].r0, k0 = raw[i].k0, v0 = raw[i].v0, r1 = raw[i].r1, k1 = raw[i].k1, v1 = raw[i].v1;
        const float rc[4] = {bflo(r0.x), bfhi(r0.x), bflo(r0.y), bfhi(r0.y)}, rp[4] = {bflo(r1.x), bfhi(r1.x), bflo(r1.y), bfhi(r1.y)};
        const float kc[4] = {bflo(k0.x), bfhi(k0.x), bflo(k0.y), bfhi(k0.y)}, kp[4] = {bflo(k1.x), bfhi(k1.x), bflo(k1.y), bfhi(k1.y)};
        const float vc[4] = {bflo(v0.x), bfhi(v0.x), bflo(v0.y), bfhi(v0.y)}, vp[4] = {bflo(v1.x), bfhi(v1.x), bflo(v1.y), bfhi(v1.y)};
        lf4 R, W, K, A, Bv, V; float bon = 0.f, ks4[4], kk4[4], ss = 0.f;
#pragma unroll
        for (int e = 0; e < 4; ++e) { ks4[e] = kc[e] + (kp[e] * pz - kc[e]) * c.muk[e]; kk4[e] = ks4[e] * c.kkw[e]; ss += kk4[e] * kk4[e]; }
        ss = row16_sum(ss);
        const float kinv = 1.0f / fmaxf(sqrtf(ss), 1e-12f);
#pragma unroll
        for (int e = 0; e < 4; ++e) {
            const float rs = rc[e] + (rp[e] * pz - rc[e]) * c.mur[e], ks = ks4[e], vs = vc[e] + (vp[e] * pz - vc[e]) * c.muv[e];
            const float aa = (float)raw[i].aa[e], kk = kk4[e] * kinv;
            const float kn = ks * (1.0f + (aa - 1.0f) * c.ka[e]);
            R[e] = rs; W[e] = (float)raw[i].wd[e]; K[e] = kn; A[e] = -kk; Bv[e] = kk * aa; V[e] = vs; bon += rs * kn * c.rk[e];
        }
        *(LAS lf4*)(buf + OFF_R + t * 64 + c4) = R; *(LAS lf4*)(buf + OFF_W + t * 64 + c4) = W; *(LAS lf4*)(buf + OFF_K + t * 64 + c4) = K;
        *(LAS lf4*)(buf + OFF_A + t * 64 + c4) = A; *(LAS lf4*)(buf + OFF_B + t * 64 + c4) = Bv;
        if ((c4 >> 4) == c.quarter) *(LAS lf4*)(buf + OFF_V + t * 16 + (c4 & 15)) = V;
        bon = row16_sum(bon);
        if (c.quarter == 0 && (ht & 15) == 0) c.bonus[m * 16 + c.hh] = bon;
    }
}
__device__ __forceinline__ void write_y(const StageCtx& c, int tau, const LAS float* buf, int ht) {
    const int idx = ht * 2, t = idx >> 4, ii = idx & 15;
    const size_t m = (size_t)c.b * SEQ + tau * TT + t;
    const lf4 p0 = *(const LAS lf4*)(buf + OFF_Y + idx * 4), p1 = *(const LAS lf4*)(buf + OFF_Y + idx * 4 + 4);
    const float y0 = (p0.x + p0.y) + (p0.z + p0.w), y1 = (p1.x + p1.y) + (p1.z + p1.w);
    *(unsigned*)(c.yraw + m * 1024 + c.hh * 64 + c.quarter * 16 + ii) = pk2(y0, y1);
}

__device__ __forceinline__ void phase(const Args& a, LAS unsigned char* lds, int tid, int lane, int wave) {
    unsigned char* ws = a.ws;
    LAS float* bufs = (LAS float*)lds;
    for (int unit = blockIdx.x; unit < 256; unit += gridDim.x) {
        StageCtx c; c.prw = (const bf16*)(ws + WS_PRW); c.aab = (const _Float16*)(ws + WS_AA); c.wdb = (const _Float16*)(ws + WS_WDEC);
        c.bonus = (float*)(ws + WS_BONUS); c.yraw = (bf16*)(ws + WS_YRAW);
        const int bh = unit >> 2; c.quarter = unit & 3; c.b = bh >> 4; c.hh = bh & 15;
        const int ht = tid - 256;
        Raw raw[2];
        __syncthreads();
        if (wave >= 4) {
            const int ch = c.hh * 64 + (ht & 15) * 4;
#pragma unroll
            for (int e = 0; e < 4; ++e) { c.mur[e] = a.mu[ch + e]; c.muk[e] = a.mu[1024 + ch + e]; c.muv[e] = a.mu[2048 + ch + e]; c.ka[e] = a.k_a[ch + e]; c.rk[e] = a.r_k[ch + e]; c.kkw[e] = a.k_k[ch + e]; }
            stage_load(c, 0, ht, raw); stage_conv(c, 0, bufs, ht, raw); stage_load(c, 1, ht, raw);
        }
        __syncthreads();
        lf2 S01 = (lf2){0.f, 0.f}, S23 = (lf2){0.f, 0.f};
        const int rg = lane >> 4, cgp = lane & 15, rloc = (wave & 3) * 4 + rg;
#pragma unroll 1
        for (int tau = 0; tau < NT; ++tau) {
            LAS float* cur = bufs + (tau & 1) * BUF_F; LAS float* nxt = bufs + ((tau + 1) & 1) * BUF_F;
            if (wave < 4) {
                const LAS lf4* R4 = (const LAS lf4*)(cur + OFF_R) + cgp; const LAS lf4* W4 = (const LAS lf4*)(cur + OFF_W) + cgp; const LAS lf4* K4 = (const LAS lf4*)(cur + OFF_K) + cgp;
                const LAS lf4* A4 = (const LAS lf4*)(cur + OFF_A) + cgp; const LAS lf4* B4 = (const LAS lf4*)(cur + OFF_B) + cgp;
                const LAS float* Vp = cur + OFF_V + rloc; LAS float* Yp = cur + OFF_Y + rloc * 4 + (cgp & 3);
#define SC_LOAD(dst, g) do { _Pragma("unroll") for (int s_ = 0; s_ < GS; ++s_) { const int t_ = (g) * GS + s_; dst[s_].a = A4[t_ * 16]; dst[s_].b = B4[t_ * 16]; dst[s_].w = W4[t_ * 16]; \
                    dst[s_].k = K4[t_ * 16]; dst[s_].r = R4[t_ * 16]; dst[s_].v = Vp[t_ * 16]; } } while (0)
#define SC_STEPS(src, g) do { _Pragma("unroll") for (int s_ = 0; s_ < GS; ++s_) { const Ops& o_ = src[s_]; \
                    lf2 p = S01 * o_.a.xy; p = S23 * o_.a.zw + p; \
                    lf2 t01 = S01 * o_.w.xy; t01 = o_.k.xy * o_.v + t01; lf2 t23 = S23 * o_.w.zw; t23 = o_.k.zw * o_.v + t23; \
                    const float sa = row16_sum(p.x + p.y); \
                    S01 = o_.b.xy * sa + t01; S23 = o_.b.zw * sa + t23; \
                    lf2 q = S01 * o_.r.xy; q = S23 * o_.r.zw + q; \
                    float y = q.x + q.y; y += dpp_f<0x128>(y); y += dpp_f<0x124>(y); \
                    Yp[((g) * GS + s_) * 64] = y; } } while (0)
                constexpr int GS = 2; Ops oa[GS], ob[GS];
                SC_LOAD(oa, 0);
#pragma unroll 2
                for (int g = 0; g < TT / GS; g += 2) {
                    SC_LOAD(ob, g + 1);
                    SC_STEPS(oa, g);
                    const int g2 = (g + 2 < TT / GS) ? g + 2 : g;
                    SC_LOAD(oa, g2);
                    SC_STEPS(ob, g + 1);
                }
#undef SC_LOAD
#undef SC_STEPS
            } else {
                if (tau + 1 < NT) stage_conv(c, tau + 1, nxt, ht, raw);
                if (tau + 2 < NT) stage_load(c, tau + 2, ht, raw);
                if (tau >= 1) write_y(c, tau - 1, nxt, ht);
            }
            __syncthreads();
        }
        if (wave >= 4) write_y(c, NT - 1, bufs + ((NT - 1) & 1) * BUF_F, ht);
    }
    __syncthreads();
}
}

__device__ __forceinline__ void p6_phase(const Args& a, int lane, int wave) {
    unsigned char* ws = a.ws;
    bf16* prw = (bf16*)(ws + WS_PRW); const bf16* yraw = (const bf16*)(ws + WS_YRAW); const float* bonus = (const float*)(ws + WS_BONUS);
    const int gw = blockIdx.x * NWAVES + wave, NGW = gridDim.x * NWAVES;
    const int c0 = 16 * lane;
    float muv[16], mug[16], lw[16], lb[16];
#pragma unroll
    for (int e = 0; e < 16; ++e) { muv[e] = a.mu[2048 + c0 + e]; mug[e] = a.mu[3072 + c0 + e]; lw[e] = a.lnx_w[c0 + e]; lb[e] = a.lnx_b[c0 + e]; }
    for (int m0 = gw * 8; m0 < M; m0 += NGW * 8)
    for (int m = m0; m < m0 + 8; ++m) {
        const bool first = (m % SEQ) == 0;
        float y[16], vc[16], vp[16], gc[16], gp[16];
        const bf16* yp = yraw + (size_t)m * 1024 + c0;
        unpack8(__builtin_nontemporal_load((const u32x4*)yp), y); unpack8(__builtin_nontemporal_load((const u32x4*)(yp + 8)), y + 8);
        const bf16* pr = prw + (size_t)m * 4096 + c0;
        unpack8(*(const u32x4*)(pr + 2048), vc); unpack8(*(const u32x4*)(pr + 2048 + 8), vc + 8);
        unpack8(*(const u32x4*)(pr + 3072), gc); unpack8(*(const u32x4*)(pr + 3072 + 8), gc + 8);
        if (first) {
#pragma unroll
            for (int e = 0; e < 16; ++e) { vp[e] = 0.f; gp[e] = 0.f; }
        } else {
            unpack8(*(const u32x4*)(pr - 4096 + 2048), vp); unpack8(*(const u32x4*)(pr - 4096 + 2048 + 8), vp + 8);
            unpack8(*(const u32x4*)(pr - 4096 + 3072), gp); unpack8(*(const u32x4*)(pr - 4096 + 3072 + 8), gp + 8);
        }
        float s = 0.f;
#pragma unroll
        for (int e = 0; e < 16; ++e) s += y[e];
        s += __shfl_xor(s, 1); s += __shfl_xor(s, 2);
        const float mean = s * (1.0f / 64.0f); float q = 0.f;
#pragma unroll
        for (int e = 0; e < 16; ++e) { y[e] -= mean; q += y[e] * y[e]; }
        q += __shfl_xor(q, 1); q += __shfl_xor(q, 2);
        const float rstd = 1.0f / sqrtf(q * (1.0f / 64.0f) + 64e-5f);
        const float bon = bonus[(size_t)m * 16 + (lane >> 2)];
        float o[16];
#pragma unroll
        for (int e = 0; e < 16; ++e) {
            const float vs = vc[e] + (vp[e] - vc[e]) * muv[e], gs = gc[e] + (gp[e] - gc[e]) * mug[e];
            const float yn = y[e] * rstd * lw[e] + lb[e] + bon * vs;
            o[e] = yn * gs * pg8::sigmoidf_(gs);
        }
        u32x4 w0, w1;
        w0.x = pk2(o[0], o[1]); w0.y = pk2(o[2], o[3]); w0.z = pk2(o[4], o[5]); w0.w = pk2(o[6], o[7]);
        w1.x = pk2(o[8], o[9]); w1.y = pk2(o[10], o[11]); w1.z = pk2(o[12], o[13]); w1.w = pk2(o[14], o[15]);
        *(u32x4*)(prw + (size_t)m * 4096 + 1024 + c0) = w0; *(u32x4*)(prw + (size_t)m * 4096 + 1024 + c0 + 8) = w1;
    }
}


#define XB_TMO      128
#define XB_XCNT(j)  (256  + 64 * (j))
#define XB_XSUB(j)  (1280 + 64 * (j))
#define XB_XGEN(j)  (2304 + 64 * (j))
#define XB_TOP      3328
#define XB_TOPGEN   3392
#define XCD_BAR_WORDS 3456
#define XB_SPIN_CAP (1u << 22)
__device__ __forceinline__ unsigned xb_ld(unsigned* p)              { return __hip_atomic_load(p, __ATOMIC_RELAXED, __HIP_MEMORY_SCOPE_AGENT); }
__device__ __forceinline__ unsigned xb_add(unsigned* p, unsigned v) { return __hip_atomic_fetch_add(p, v, __ATOMIC_RELAXED, __HIP_MEMORY_SCOPE_AGENT); }
__device__ __forceinline__ unsigned xb_xcc_id() { return (unsigned)__builtin_amdgcn_s_getreg((3 << 11) | 20) & 0xFu; }
#define XB_SPIN(cond, bar) do { unsigned _sp = 0; while (cond) { __builtin_amdgcn_s_sleep(1); \
    if ((++_sp & 255u) == 0u) { if (xb_ld(&(bar)[XB_TMO])) break; if (_sp > XB_SPIN_CAP) { atomicAdd(&(bar)[XB_TMO], 1u); break; } } } } while (0)
struct XcdBarrier { unsigned* bar; unsigned x; volatile LAS unsigned* st; };
__device__ __forceinline__ XcdBarrier xcd_barrier_post(unsigned* bar, volatile LAS unsigned* st) {
    XcdBarrier b; b.bar = bar; b.x = xb_xcc_id(); b.st = st;
    if (threadIdx.x == 0) (void)xb_add(&bar[XB_XCNT(b.x)], 1u);
    return b;
}
__device__ __forceinline__ void xcd_barrier_complete(unsigned* bar, unsigned x, unsigned& nloc, unsigned& nx) {
    const unsigned G = gridDim.x * gridDim.y * gridDim.z;
    unsigned sum, cnt, mine, sp = 0u;
    for (;;) {
        sum = 0u; cnt = 0u; mine = 0u;
#pragma unroll
        for (unsigned j = 0; j < 16; ++j) { const unsigned c = xb_ld(&bar[XB_XCNT(j)]); sum += c; cnt += (c > 0u) ? 1u : 0u; mine = (j == x) ? c : mine; }
        if (sum == G) break;
        __builtin_amdgcn_s_sleep(1);
        if ((++sp & 255u) == 0u) { if (xb_ld(&bar[XB_TMO])) break; if (sp > XB_SPIN_CAP) { atomicAdd(&bar[XB_TMO], 1u); break; } }
    }
    nloc = mine > 0u ? mine : 1u; nx = cnt > 0u ? cnt : 1u;
}
__device__ __forceinline__ void xcd_barrier(const XcdBarrier& b) {
    asm volatile("s_waitcnt vmcnt(0)" ::: "memory");
    __syncthreads();
    if (threadIdx.x == 0) {
        unsigned* bar = b.bar;
        __builtin_amdgcn_s_waitcnt(0);
        unsigned nloc = b.st[0], nx = b.st[1];
        if (nloc == 0u) { xcd_barrier_complete(bar, b.x, nloc, nx); b.st[0] = nloc; b.st[1] = nx; }
        const unsigned old = xb_add(&bar[XB_XSUB(b.x)], 1u);
        const unsigned gen = old / nloc;
        if (old + 1u == (gen + 1u) * nloc) {
            __builtin_amdgcn_fence(__ATOMIC_RELEASE, "agent");
            asm volatile("s_waitcnt vmcnt(0)" ::: "memory");
            const unsigned og = xb_add(&bar[XB_TOP], 1u);
            const unsigned tg = og / nx;
            if (og + 1u == (tg + 1u) * nx) xb_add(&bar[XB_TOPGEN], 1u);
            else XB_SPIN(xb_ld(&bar[XB_TOPGEN]) == tg, bar);
            __builtin_amdgcn_fence(__ATOMIC_ACQUIRE, "agent");
            xb_add(&bar[XB_XGEN(b.x)], 1u);
            asm volatile("s_waitcnt vmcnt(0)" ::: "memory");
        } else {
            XB_SPIN(xb_ld(&bar[XB_XGEN(b.x)]) == gen, bar);
            __builtin_amdgcn_fence(__ATOMIC_ACQUIRE, "agent");
            asm volatile("s_waitcnt vmcnt(0)" ::: "memory");
        }
    }
    __syncthreads();
}

constexpr int N_PHASES = 9;
__device__ __forceinline__ const Args* fresh_args() {
    auto p = __builtin_amdgcn_kernarg_segment_ptr(); asm volatile("" : "+s"(p)); return (const Args*)p;
}
__global__ void __launch_bounds__(NTHR, 2) fwd_kernel(Args a_in) {
    extern __shared__ __attribute__((aligned(16))) unsigned char lds_raw[];
    LAS unsigned char* lds = (LAS unsigned char*)lds_raw;
    const int tid = threadIdx.x, lane = tid & 63, wave = __builtin_amdgcn_readfirstlane(tid >> 6);
    const int G = gridDim.x;
    const int lo = a_in.ph_lo, hi = a_in.ph_hi, rep_mask = a_in.rep_mask;
#ifndef PH_MASK
#define PH_MASK 0x1ff
#endif
#define IN(k) (((PH_MASK >> (k)) & 1) && lo <= (k) && (k) < hi)
#define REP(k) for (int rep_ = 0; rep_ < 1 + ((rep_mask >> (k)) & 1); ++rep_)
#define SEAM(k) do { if (IN(k) && IN((k) + 1)) { xcd_barrier(xbar); } } while (0)
    volatile LAS unsigned* misc = (volatile LAS unsigned*)(lds + LDS_MISC);
    if (tid < 2) misc[tid] = 0u;
    __syncthreads();
    XcdBarrier xbar; xbar.bar = (unsigned*)(a_in.ws + WS_BAR); xbar.x = 0; xbar.st = misc;
    if (hi - lo > 1) xbar = xcd_barrier_post((unsigned*)(a_in.ws + WS_BAR), misc);
    if (hi > N_PHASES) cg::this_grid().sync();
    if (IN(0)) REP(0) { const Args a = *fresh_args(); unsigned char* ws = a.ws; (void)ws; p0_phase(a, lds, tid, lane, wave); }
    SEAM(0);
    if (IN(1)) REP(1) { const Args a = *fresh_args(); unsigned char* ws = a.ws; (void)ws; p1_phase(a, lds, tid, lane, wave); __syncthreads(); }
    SEAM(1);
    if (IN(2)) REP(2) { const Args a = *fresh_args(); unsigned char* ws = a.ws; (void)ws;
        pg8::Gemm g{(const bf16*)(ws + WS_H), (const bf16*)(ws + WS_WIN), M, NPAD, D, D}; pg8::StaticOrder S; S.init(M, NPAD, G, (int)blockIdx.x);
        pg8::EpiIn E{(bf16*)(ws + WS_PRW), (bf16*)(ws + WS_PAT), (bf16*)(ws + WS_PG), (bf16*)(ws + WS_PWA)};
        pg8::gemm_phase<pg8::EpiIn, pg8::StaticOrder, true>(lds, g, S, E);
    }
    SEAM(2);
    if (IN(3)) REP(3) { const Args a = *fresh_args(); unsigned char* ws = a.ws; (void)ws; p3_phase(a, lane, wave); }
    SEAM(3);
    if (IN(4)) { const Args a = *fresh_args(); unsigned char* ws = a.ws; (void)ws;
        int kl = 128; asm volatile("" : "+s"(kl));
        pg8::Gemm g{(const bf16*)(ws + WS_A2), (const bf16*)(ws + WS_WLORA), M, 2048, kl, 128}; pg8::StaticOrder S; S.init(M, 2048, G, (int)blockIdx.x);
        pg8::EpiLora E{(_Float16*)(ws + WS_WDEC), (_Float16*)(ws + WS_AA), a.w0, a.a0};
        const bool att_first = ((blockIdx.x >> 3) & 1) != 0;
        if (att_first) att::phase(a, lds, tid, lane, wave);
        __syncthreads();
        pg8::gemm_phase<pg8::EpiLora, pg8::StaticOrder, true>(lds, g, S, E);
        __syncthreads();
        if (!att_first) att::phase(a, lds, tid, lane, wave);
    }
    SEAM(4);
    if (IN(5)) REP(5) { const Args a = *fresh_args(); unsigned char* ws = a.ws; (void)ws; scan::phase(a, lds, tid, lane, wave); }
    SEAM(5);
    if (IN(6)) REP(6) { const Args a = *fresh_args(); unsigned char* ws = a.ws; (void)ws;
        const bool rows_first = ((blockIdx.x >> 3) & 1) == 0;
        if (rows_first) p6_phase(a, lane, wave);
        __syncthreads();
        pg8::Gemm g{(const bf16*)(ws + WS_PAT), (const bf16*)(ws + WS_WUPA), M, 2048, 1024, 2560}; pg8::StaticOrder S; S.init(M, 2048, G, (int)blockIdx.x);
        pg8::EpiUp<false> E{(bf16*)(ws + WS_MB), (const bf16*)(ws + WS_PG), 2048};
        pg8::gemm_phase<pg8::EpiUp<false>, pg8::StaticOrder, true>(lds, g, S, E);
        __syncthreads();
        if (!rows_first) p6_phase(a, lane, wave);
    }
    SEAM(6);
    if (IN(7)) { const Args a = *fresh_args(); unsigned char* ws = a.ws; (void)ws;
        pg8::Gemm g{(const bf16*)(ws + WS_PRW) + 1024, (const bf16*)(ws + WS_WUPR), M, 2048, 1024, 4096}; pg8::StaticOrder S; S.init(M, 2048, G, (int)blockIdx.x);
        pg8::EpiUp<true> E{(bf16*)(ws + WS_MB), (const bf16*)(ws + WS_PG), 0};
        pg8::gemm_phase<pg8::EpiUp<true>, pg8::StaticOrder, true>(lds, g, S, E);
    }
    SEAM(7);
    if (IN(8)) REP(8) { const Args a = *fresh_args(); unsigned char* ws = a.ws; (void)ws;
        pg8::Gemm g{(const bf16*)(ws + WS_MB), (const bf16*)(ws + WS_WO), M, 2048, 2048, 2048}; pg8::StaticOrder S; S.init(M, 2048, G, (int)blockIdx.x);
        pg8::EpiOut E{a.x, a.out, (const float*)(ws + WS_GATEF)};
        pg8::gemm_phase<pg8::EpiOut, pg8::StaticOrder, true>(lds, g, S, E);
    }
#undef IN
#undef SEAM
}

extern "C" void kernel_launch(void* const* d_in, const int* in_sizes, int n_in, void* d_out, int out_size, void* d_ws, size_t ws_size, hipStream_t stream) {
    static int grid = 0;
    if (grid == 0) {
        if (n_in != 22 || in_sizes[0] != M * D || out_size != M * D || ws_size < WS_END) { fprintf(stderr, "kernel_launch: unexpected shapes (n_in %d, in0 %d, out %d, ws %zu); nothing launched\n", n_in, n_in > 0 ? in_sizes[0] : -1, out_size, ws_size); grid = -1; return; }
        int dev = 0, cus = 0, per_cu = 0;
        if (hipGetDevice(&dev) != hipSuccess || hipDeviceGetAttribute(&cus, hipDeviceAttributeMultiprocessorCount, dev) != hipSuccess) { grid = -1; return; }
        if (hipFuncSetAttribute((const void*)fwd_kernel, hipFuncAttributeMaxDynamicSharedMemorySize, LDS_BYTES) != hipSuccess) { fprintf(stderr, "kernel_launch: hipFuncSetAttribute failed\n"); grid = -1; return; }
        if (hipOccupancyMaxActiveBlocksPerMultiprocessor(&per_cu, (const void*)fwd_kernel, NTHR, LDS_BYTES) != hipSuccess || per_cu < 1) { fprintf(stderr, "kernel_launch: occupancy query failed (%d)\n", per_cu); (void)hipGetLastError(); per_cu = 1; }
        grid = cus * 1;
        if (grid > cus * per_cu) grid = cus * per_cu;
    }
    if (grid < 0) return;
    Args a{};
    const float** ap = (const float**)&a;
    for (int i = 0; i < 22; ++i) ap[i] = (const float*)d_in[i];
    a.out = (float*)d_out; a.ws = (unsigned char*)d_ws; a.rep_mask = REP_MASK;
#if MK_SPLIT
    for (int p = 0; p < N_PHASES; ++p) { a.ph_lo = p; a.ph_hi = p + 1; hipLaunchKernelGGL(fwd_kernel, dim3(grid), dim3(NTHR), LDS_BYTES, stream, a); }
#else
    a.ph_lo = 0; a.ph_hi = N_PHASES;
    if (hipMemsetAsync((char*)d_ws + WS_BAR, 0, 16384, stream) != hipSuccess) { fprintf(stderr, "kernel_launch: memset of the barrier words failed\n"); return; }
    void* args[] = {&a};
    hipError_t e = hipLaunchCooperativeKernel((const void*)fwd_kernel, dim3(grid), dim3(NTHR), args, LDS_BYTES, stream);
    if (e != hipSuccess) fprintf(stderr, "cooperative launch failed: %s (grid %d)\n", hipGetErrorString(e), grid);
#endif
}
```

```cpp
#include <hip/hip_runtime.h>
#include <hip/hip_cooperative_groups.h>
#include <cstdio>
#include <cstdint>
namespace cg = cooperative_groups;

#define REP_MASK 0
#ifndef MK_SPLIT
#define MK_SPLIT 0
#endif

namespace pg8 {
#define PG8_LAS __attribute__((address_space(3)))
typedef unsigned short bf16_t;
typedef short bf16x8 __attribute__((ext_vector_type(8)));
typedef float f32x4 __attribute__((ext_vector_type(4)));
typedef unsigned u32x4 __attribute__((ext_vector_type(4)));
typedef unsigned u32x2 __attribute__((ext_vector_type(2)));
constexpr int BM = 256, BK = 64, HALF = 128, HTB = HALF * BK * 2, STAGE_BYTES = 8 * HTB, NXCD = 8, WGM = 8;

__host__ __device__ __forceinline__ int lds_byte(int r, int c) { const int st = (r >> 4) * 2 + (c >> 5), rr = r & 15, cc = c & 31, ob = rr * 64 + cc * 2; return st * 1024 + (ob ^ (((ob >> 9) & 1) << 5)); }
__host__ __device__ __forceinline__ void stage_rc(int b, int& R, int& C) { const int st = b / 1024, sb = b % 1024, swz = sb ^ (((sb >> 9) & 1) << 5); R = (st >> 1) * 16 + swz / 64; C = (st & 1) * 32 + (swz % 64) / 2; }
__host__ __device__ __forceinline__ int perm32(int rho) { const int n = rho >> 4, i = rho & 15; return 8 * (i >> 2) + 4 * n + (i & 3); }

struct Unit { int pm, pn; };
struct Gemm { const bf16_t* A; const bf16_t* Bt; int M, N, K, lda; };

struct StaticOrder {
    int nM, nN, nwg, G, c;
    __host__ __device__ void init(int M, int N, int G_, int c_) { nM = M / BM; nN = N / BM; nwg = nM * nN; G = G_; c = c_; }
    __host__ __device__ bool next(int i, Unit& u) const {
        const long L = (long)i * G + c; if (L >= nwg) return false;
        int wgid = (int)L; { const int q = nwg / NXCD, r = nwg % NXCD, xcd = wgid % NXCD, off = wgid / NXCD; wgid = (xcd < r ? xcd * (q + 1) : r * (q + 1) + (xcd - r) * q) + off; }
        const int nig = WGM * nN, gid = wgid / nig, fm = gid * WGM, gsz = (nM - fm) < WGM ? (nM - fm) : WGM;
        u.pm = fm + ((wgid % nig) % gsz); u.pn = (wgid % nig) / gsz; return true;
    }
};

__device__ __forceinline__ unsigned cvt_pk_bf16(float lo, float hi) { unsigned r; asm volatile("v_cvt_pk_bf16_f32 %0, %1, %2" : "=v"(r) : "v"(lo), "v"(hi)); return r; }
__device__ __forceinline__ float bflo(unsigned u) { return __uint_as_float(u << 16); }
__device__ __forceinline__ float bfhi(unsigned u) { return __uint_as_float(u & 0xffff0000u); }
__device__ __forceinline__ float sigmoidf_(float v) { return __builtin_amdgcn_rcpf(1.0f + __builtin_amdgcn_exp2f(-1.4426950408889634f * v)); }


struct EpiIn {
    static constexpr bool PERM = true;
    bf16_t *prw, *pat, *pg, *pwa;
    __device__ __forceinline__ void operator()(const f32x4 (&acc)[2][2][4][2], const Unit& u, int wr, int wc, int fr, int fq) const {
        bf16_t* base; int ldc; bool sig = false; const int pn = u.pn;
        if (pn < 16) { base = prw + pn * 256; ldc = 4096; }
        else if (pn < 26) { base = pat + (pn - 16) * 256; ldc = 2560; }
        else if (pn < 42) { base = pg + (pn - 26) * 256; ldc = 4096; sig = true; }
        else { base = pwa; ldc = 256; }
        const int row0 = u.pm * BM + wr * 64 + fr, col0 = wc * 32 + 8 * fq;
#pragma unroll
        for (int ai = 0; ai < 2; ++ai)
#pragma unroll
            for (int m = 0; m < 4; ++m) { bf16_t* rowp = base + (size_t)(row0 + ai * HALF + m * 16) * ldc + col0;
#pragma unroll
                for (int bj = 0; bj < 2; ++bj) { f32x4 v0 = acc[ai][bj][m][0], v1 = acc[ai][bj][m][1];
                    if (sig) {
#pragma unroll
                        for (int e = 0; e < 4; ++e) { v0[e] = sigmoidf_(v0[e]); v1[e] = sigmoidf_(v1[e]); } }
                    u32x4 w; w.x = cvt_pk_bf16(v0[0], v0[1]); w.y = cvt_pk_bf16(v0[2], v0[3]); w.z = cvt_pk_bf16(v1[0], v1[1]); w.w = cvt_pk_bf16(v1[2], v1[3]);
                    *(u32x4*)(rowp + bj * HALF) = w; } }
    }
};

typedef _Float16 h16x8 __attribute__((ext_vector_type(8)));
struct EpiLora {
    static constexpr bool PERM = true;
    _Float16 *wdec, *aa; const float *w0, *a0;
    __device__ __forceinline__ void operator()(const f32x4 (&acc)[2][2][4][2], const Unit& u, int wr, int wc, int fr, int fq) const {
        const bool isdec = u.pn < 4;
        _Float16* base = isdec ? wdec : aa; const float* bias = isdec ? w0 : a0;
        const int colt = (isdec ? u.pn : u.pn - 4) * 256;
        const int row0 = u.pm * BM + wr * 64 + fr, col0 = colt + wc * 32 + 8 * fq;
        f32x4 bv[2][2];
#pragma unroll
        for (int bj = 0; bj < 2; ++bj)
#pragma unroll
            for (int n = 0; n < 2; ++n) bv[bj][n] = *(const f32x4*)(bias + col0 + bj * HALF + 4 * n);
#pragma unroll
        for (int ai = 0; ai < 2; ++ai)
#pragma unroll
            for (int m = 0; m < 4; ++m) { _Float16* rowp = base + (size_t)(row0 + ai * HALF + m * 16) * 1024 + col0;
#pragma unroll
                for (int bj = 0; bj < 2; ++bj) {
                    const f32x4 v0 = acc[ai][bj][m][0] + bv[bj][0], v1 = acc[ai][bj][m][1] + bv[bj][1]; h16x8 o;
#pragma unroll
                    for (int e = 0; e < 8; ++e) { const float v = e < 4 ? v0[e & 3] : v1[e & 3];
                        float r = sigmoidf_(v);
                        if (isdec) r = __builtin_amdgcn_exp2f(-0.6065306597f * 1.4426950408889634f * r);
                        o[e] = (_Float16)r; }
                    *(h16x8*)(rowp + bj * HALF) = o; }
                if (m & 1) asm volatile("" ::: "memory"); }
    }
};

template <bool ADD> struct EpiUp {
    static constexpr bool PERM = true;
    bf16_t* mbuf; const bf16_t* pg; int goff;
    __device__ __forceinline__ void operator()(const f32x4 (&acc)[2][2][4][2], const Unit& u, int wr, int wc, int fr, int fq) const {
        const int row0 = u.pm * BM + wr * 64 + fr, col0 = u.pn * BM + wc * 32 + 8 * fq;
#pragma unroll
        for (int ai = 0; ai < 2; ++ai)
#pragma unroll
            for (int m = 0; m < 4; ++m) { const size_t row = (size_t)(row0 + ai * HALF + m * 16);
#pragma unroll
                for (int bj = 0; bj < 2; ++bj) { const int col = col0 + bj * HALF;
                    const u32x4 g = __builtin_nontemporal_load((const u32x4*)(pg + row * 4096 + goff + col));
                    f32x4 v0 = acc[ai][bj][m][0], v1 = acc[ai][bj][m][1];
                    v0[0] *= bflo(g.x); v0[1] *= bfhi(g.x); v0[2] *= bflo(g.y); v0[3] *= bfhi(g.y);
                    v1[0] *= bflo(g.z); v1[1] *= bfhi(g.z); v1[2] *= bflo(g.w); v1[3] *= bfhi(g.w);
                    if (ADD) { const u32x4 p = __builtin_nontemporal_load((const u32x4*)(mbuf + row * 2048 + col));
                        v0[0] += bflo(p.x); v0[1] += bfhi(p.x); v0[2] += bflo(p.y); v0[3] += bfhi(p.y);
                        v1[0] += bflo(p.z); v1[1] += bfhi(p.z); v1[2] += bflo(p.w); v1[3] += bfhi(p.w); }
                    u32x4 w; w.x = cvt_pk_bf16(v0[0], v0[1]); w.y = cvt_pk_bf16(v0[2], v0[3]); w.z = cvt_pk_bf16(v1[0], v1[1]); w.w = cvt_pk_bf16(v1[2], v1[3]);
                    *(u32x4*)(mbuf + row * 2048 + col) = w; } }
    }
};

struct EpiOut {
    static constexpr bool PERM = false;
    const float* x; float* out; const float* gatef;
    __device__ __forceinline__ void operator()(const f32x4 (&acc)[2][2][4][2], const Unit& u, int wr, int wc, int fr, int fq) const {
        const int row0 = u.pm * BM + wr * 64 + fr, col0 = u.pn * BM + wc * 32 + 4 * fq; const int b = u.pm >> 4;
        f32x4 gv[2][2];
#pragma unroll
        for (int bj = 0; bj < 2; ++bj)
#pragma unroll
            for (int n = 0; n < 2; ++n) gv[bj][n] = *(const f32x4*)(gatef + b * 2048 + col0 + bj * HALF + n * 16);
#pragma unroll
        for (int ai = 0; ai < 2; ++ai)
#pragma unroll
            for (int m = 0; m < 4; ++m) { const size_t off = (size_t)(row0 + ai * HALF + m * 16) * 2048 + col0;
#pragma unroll
                for (int bj = 0; bj < 2; ++bj)
#pragma unroll
                    for (int n = 0; n < 2; ++n) { const f32x4 xv = *(const f32x4*)(x + off + bj * HALF + n * 16);
                        *(f32x4*)(out + off + bj * HALF + n * 16) = xv + gv[bj][n] * acc[ai][bj][m][n]; }
                if (m & 1) asm volatile("" ::: "memory"); }
    }
};

template <class Epi, class Sched, bool ALIGN_EPI>
__device__ __forceinline__ void gemm_phase(PG8_LAS unsigned char* lds, const Gemm g, const Sched& S, const Epi& E) {
    const int tid = threadIdx.x, wid = __builtin_amdgcn_readfirstlane(tid >> 6), lane = tid & 63, wr = wid >> 2, wc = wid & 3, fr = lane & 15, fq = lane >> 4;
    const int K = g.K, nt = K / BK, lda = g.lda;
    unsigned voffA[2], voffB[2];
#pragma unroll
    for (int i = 0; i < 2; ++i) { int R, C; stage_rc(tid * 16 + i * 8192, R, C); const int Rb = Epi::PERM ? ((R & ~31) + perm32(R & 31)) : R;
        voffA[i] = (unsigned)(R * lda + C) * 2u; voffB[i] = (unsigned)(Rb * K + C) * 2u; }
    const size_t kstep = (size_t)(BK * 2);
    const size_t hstepA = (size_t)HALF * lda * 2, hstepB = (size_t)HALF * K * 2;
    const size_t tstepA = 2 * hstepA, tstepB = 2 * hstepB;
    const unsigned ldsw = (unsigned)wid * 1024u;
    const int aoff = lds_byte(wr * 64 + fr, fq * 8), boff = lds_byte(wc * 32 + fr, fq * 8);
#define PG8_SA(b, h) (((b) * 2 + (h)) * HTB)
#define PG8_SB(b, h) ((4 + (b) * 2 + (h)) * HTB)
#define PG8_STAGE(bufoff, gbase, voff) do { _Pragma("unroll") for (int _i = 0; _i < 2; ++_i) \
        __builtin_amdgcn_global_load_lds((const unsigned*)((const char*)(gbase) + (voff)[_i]), (PG8_LAS unsigned*)(lds + (bufoff) + ldsw + _i * 8192), 16, 0, 0); } while (0)
#define PG8_LDA(dst, b, h) do { _Pragma("unroll") for (int m = 0; m < 4; ++m) _Pragma("unroll") for (int k = 0; k < 2; ++k) dst[m][k] = *(const PG8_LAS bf16x8*)(lds + PG8_SA(b, h) + aoff + m * 2048 + k * 1024); } while (0)
#define PG8_LDB(dst, b, h) do { _Pragma("unroll") for (int n = 0; n < 2; ++n) _Pragma("unroll") for (int k = 0; k < 2; ++k) dst[n][k] = *(const PG8_LAS bf16x8*)(lds + PG8_SB(b, h) + boff + n * 2048 + k * 1024); } while (0)
#define PG8_MMA(ai, bj, At, Bt) do { __builtin_amdgcn_s_setprio(1); _Pragma("unroll") for (int m = 0; m < 4; ++m) _Pragma("unroll") for (int n = 0; n < 2; ++n) _Pragma("unroll") for (int k = 0; k < 2; ++k) \
        acc[ai][bj][m][n] = __builtin_amdgcn_mfma_f32_16x16x32_bf16(Bt[n][k], At[m][k], acc[ai][bj][m][n], 0, 0, 0); __builtin_amdgcn_s_setprio(0); } while (0)
#define PG8_WAIT_V(n) asm volatile("s_waitcnt vmcnt(" #n ")" ::: "memory")
#define PG8_WAIT_L(n) asm volatile("s_waitcnt lgkmcnt(" #n ")" ::: "memory")
#define PG8_BAR __builtin_amdgcn_s_barrier()
#define PG8_SCHED __builtin_amdgcn_sched_barrier(0)
    Unit cur, nxt; int ui = 0;
    if (!S.next(0, cur)) return;
    f32x4 acc[2][2][4][2];
#pragma unroll
    for (int a = 0; a < 2; ++a)
#pragma unroll
        for (int b = 0; b < 2; ++b)
#pragma unroll
            for (int m = 0; m < 4; ++m)
#pragma unroll
                for (int n = 0; n < 2; ++n) acc[a][b][m][n] = (f32x4){0.f, 0.f, 0.f, 0.f};
    bf16x8 At[4][2], B0[2][2], B1[2][2];
    const char* cA = (const char*)g.A + (size_t)cur.pm * tstepA; const char* cB = (const char*)g.Bt + (size_t)cur.pn * tstepB;
    PG8_STAGE(PG8_SB(0, 0), cB, voffB); PG8_STAGE(PG8_SB(0, 1), cB + hstepB, voffB); PG8_STAGE(PG8_SA(0, 0), cA, voffA); PG8_STAGE(PG8_SA(0, 1), cA + hstepA, voffA);
    if (wr == 1) PG8_BAR;
    PG8_WAIT_V(2); PG8_BAR;
    PG8_STAGE(PG8_SB(1, 0), cB + kstep, voffB); PG8_STAGE(PG8_SA(1, 0), cA + kstep, voffA); PG8_STAGE(PG8_SB(1, 1), cB + hstepB + kstep, voffB);
    PG8_WAIT_V(6); PG8_BAR;
    for (;;) {
        const bool has_next = S.next(ui + 1, nxt);
        const char* nA = has_next ? (const char*)g.A + (size_t)nxt.pm * tstepA : cA; const char* nB = has_next ? (const char*)g.Bt + (size_t)nxt.pn * tstepB : cB;
        for (int t = 0; t < nt; t += 2) {
            const bool last = (t == nt - 2);
            const char* a1 = cA + (size_t)(t + 1) * kstep;
            const char* a2 = last ? nA : cA + (size_t)(t + 2) * kstep; const char* b2 = last ? nB : cB + (size_t)(t + 2) * kstep;
            const char* a3 = a2 + kstep; const char* b3 = b2 + kstep;
            PG8_LDB(B0, 0, 0); PG8_LDB(B1, 0, 1); PG8_SCHED; PG8_LDA(At, 0, 0); PG8_STAGE(PG8_SA(1, 1), a1 + hstepA, voffA);
            PG8_WAIT_V(8); PG8_WAIT_L(0); PG8_BAR; PG8_MMA(0, 0, At, B0); PG8_MMA(0, 1, At, B1); PG8_BAR; PG8_SCHED;
            PG8_LDA(At, 0, 1); PG8_STAGE(PG8_SB(0, 0), b2, voffB); PG8_STAGE(PG8_SB(0, 1), b2 + hstepB, voffB); PG8_STAGE(PG8_SA(0, 0), a2, voffA);
            PG8_WAIT_V(8); PG8_WAIT_L(0); PG8_BAR; PG8_MMA(1, 0, At, B0); PG8_MMA(1, 1, At, B1); PG8_BAR; PG8_SCHED;
            PG8_LDB(B0, 1, 0); PG8_LDB(B1, 1, 1); PG8_SCHED; PG8_LDA(At, 1, 0); PG8_STAGE(PG8_SA(0, 1), a2 + hstepA, voffA);
            PG8_WAIT_V(8); PG8_WAIT_L(0); PG8_BAR; PG8_MMA(0, 0, At, B0); PG8_MMA(0, 1, At, B1); PG8_BAR; PG8_SCHED;
            PG8_LDA(At, 1, 1); PG8_STAGE(PG8_SB(1, 0), b3, voffB); PG8_STAGE(PG8_SB(1, 1), b3 + hstepB, voffB); PG8_STAGE(PG8_SA(1, 0), a3, voffA);
            PG8_WAIT_V(8); PG8_WAIT_L(0); PG8_BAR; PG8_MMA(1, 0, At, B0); PG8_MMA(1, 1, At, B1); PG8_BAR; PG8_SCHED;
        }
        if constexpr (ALIGN_EPI) { if (wr == 0) PG8_BAR; }
        E(acc, cur, wr, wc, fr, fq);
        if (!has_next) break;
#pragma unroll
        for (int a = 0; a < 2; ++a)
#pragma unroll
            for (int b = 0; b < 2; ++b)
#pragma unroll
                for (int m = 0; m < 4; ++m)
#pragma unroll
                    for (int n = 0; n < 2; ++n) acc[a][b][m][n] = (f32x4){0.f, 0.f, 0.f, 0.f};
        cur = nxt; cA = nA; cB = nB; ++ui;
        if constexpr (ALIGN_EPI) { if (wr == 1) PG8_BAR; }
    }
    PG8_WAIT_V(0);
    if constexpr (!ALIGN_EPI) { if (wr == 0) PG8_BAR; }
    PG8_BAR;
#undef PG8_SA
#undef PG8_SB
#undef PG8_STAGE
#undef PG8_LDA
#undef PG8_LDB
#undef PG8_MMA
#undef PG8_WAIT_V
#undef PG8_WAIT_L
#undef PG8_BAR
#undef PG8_SCHED
}
}

#define LAS __attribute__((address_space(3)))
typedef unsigned short bf16;
typedef float f32x4 __attribute__((ext_vector_type(4)));
typedef float f32x16 __attribute__((ext_vector_type(16)));
typedef unsigned u32x4 __attribute__((ext_vector_type(4)));
typedef unsigned u32x2 __attribute__((ext_vector_type(2)));
typedef short bf16x8 __attribute__((ext_vector_type(8)));
typedef _Float16 h16x4 __attribute__((ext_vector_type(4)));
typedef _Float16 h16x8 __attribute__((ext_vector_type(8)));

constexpr int NWAVES = 8, NTHR = 512;
constexpr int D = 2048, BATCH = 4, SEQ = 4096, M = BATCH * SEQ;
constexpr int RW = 1024, RW_COLS = 4224, AT_COLS = 2560, IN_COLS = 10880, NPAD = 11008;
constexpr size_t MiB = 1u << 20;
constexpr size_t WS_MODP = 0;
constexpr size_t WS_GATEF = 1 * MiB + MiB / 2;
constexpr size_t WS_BAR = 1 * MiB + MiB / 2 + 65536;
constexpr size_t WS_BONUS = 2 * MiB;
constexpr size_t WS_WLORA = 3 * MiB;
constexpr size_t WS_WUPR = 4 * MiB, WS_WUPA = 8 * MiB, WS_WO = 12 * MiB;
constexpr size_t WS_PRW = 20 * MiB;
constexpr size_t WS_PAT = 148 * MiB;
constexpr size_t WS_PG = 228 * MiB;
constexpr size_t WS_PWA = 356 * MiB;
constexpr size_t WS_H = 364 * MiB;
constexpr size_t WS_WIN = 428 * MiB;
constexpr size_t WS_A2 = 364 * MiB;
constexpr size_t WS_WDEC = 368 * MiB, WS_KK = 400 * MiB, WS_AA = 432 * MiB;
constexpr size_t WS_YRAW = 464 * MiB;
constexpr size_t WS_MB = 368 * MiB;
constexpr size_t WS_END = 512 * MiB;
constexpr int LDS_BYTES = 147456;
constexpr int LDS_MISC = 147200;

struct Args {
    const float *x, *c, *ada_w, *ada_b, *norm_g, *w_in, *mu, *w0, *w2, *a0, *a2, *k_k, *k_a, *r_k, *lnx_w, *lnx_b, *q_norm, *k_norm, *sinks, *w_up_r, *w_up_a, *w_o;
    float* out; unsigned char* ws; int ph_lo, ph_hi, rep_mask, pad;
};

__device__ __forceinline__ unsigned f2bf(float f) { unsigned u = __builtin_bit_cast(unsigned, f); return (u + 0x7fffu + ((u >> 16) & 1u)) >> 16; }
__device__ __forceinline__ unsigned pk2(float lo, float hi) { return pg8::cvt_pk_bf16(lo, hi); }
__device__ __forceinline__ float bflo(unsigned u) { return __uint_as_float(u << 16); }
__device__ __forceinline__ float bfhi(unsigned u) { return __uint_as_float(u & 0xffff0000u); }
template <int CTRL> __device__ __forceinline__ float dpp_f(float x) { return __int_as_float(__builtin_amdgcn_update_dpp(0, __float_as_int(x), CTRL, 0xf, 0xf, false)); }
__device__ __forceinline__ float row16_sum(float x) {
    x += dpp_f<0x128>(x); x += dpp_f<0x124>(x); x += dpp_f<0x122>(x); x += dpp_f<0x121>(x); return x;
}
__device__ __forceinline__ float wave_sum(float v) { v = row16_sum(v); v += __shfl_xor(v, 16); v += __shfl_xor(v, 32); return v; }
__device__ __forceinline__ float quad4_sum(float x) { x += dpp_f<0xB1>(x); x += dpp_f<0x4E>(x); return x; }
__device__ __forceinline__ float oct8_sum(float x) { x = quad4_sum(x); x += dpp_f<0x141>(x); return x; }
__device__ __forceinline__ void unpack8(const u32x4 v, float* f) { f[0] = bflo(v.x); f[1] = bfhi(v.x); f[2] = bflo(v.y); f[3] = bfhi(v.y); f[4] = bflo(v.z); f[5] = bfhi(v.z); f[6] = bflo(v.w); f[7] = bfhi(v.w); }

__device__ __forceinline__ void p0_transpose_item(const float* W, int Nsrc, int sc0, int k0, bf16* WT, int Kdst, int dr0, bool zero, LAS float* scr, int lane) {
    if (!zero) {
#pragma unroll 8
        for (int i = 0; i < 32; ++i) { const int kk = 2 * i + (lane >> 5); scr[kk * 33 + (lane & 31)] = __builtin_nontemporal_load(W + (size_t)(k0 + kk) * Nsrc + sc0 + (lane & 31)); }
    }
    asm volatile("s_waitcnt lgkmcnt(0)" ::: "memory");
    const int c = lane & 7;
#pragma unroll
    for (int j = 0; j < 4; ++j) { const int n = (lane >> 3) + 8 * j; const LAS float* s = scr + (8 * c) * 33 + n;
        u32x4 o;
        if (zero) { o = (u32x4){0u, 0u, 0u, 0u}; }
        else { o.x = pk2(s[0 * 33], s[1 * 33]); o.y = pk2(s[2 * 33], s[3 * 33]); o.z = pk2(s[4 * 33], s[5 * 33]); o.w = pk2(s[6 * 33], s[7 * 33]); }
        *(u32x4*)(WT + (size_t)(dr0 + n) * Kdst + k0 + 8 * c) = o; }
    asm volatile("s_waitcnt lgkmcnt(0)" ::: "memory");
}
__device__ __forceinline__ int win_src_col(int n0) {
    if (n0 < 4096) return n0;
    if (n0 < 6656) return 4224 + (n0 - 4096);
    if (n0 < 10752) return 6784 + (n0 - 6656);
    return 4096 + (n0 - 10752);
}
__device__ __forceinline__ void p0_phase(const Args& a, LAS unsigned char* lds, int tid, int lane, int wave) {
    unsigned char* ws = a.ws;
    const int gw = blockIdx.x * NWAVES + wave, NGW = gridDim.x * NWAVES;
    for (int task = wave * (int)gridDim.x + (int)blockIdx.x; task < 16 * 24; task += NGW) {
        const int kc = task / 24, cgp = task % 24, col = cgp * 256 + lane * 4;
        f32x4 acc[4]; float c0[4], c1[4];
#pragma unroll
        for (int b = 0; b < 4; ++b) { acc[b] = (f32x4){0.f, 0.f, 0.f, 0.f}; c0[b] = a.c[b * 2048 + kc * 128 + lane]; c1[b] = a.c[b * 2048 + kc * 128 + 64 + lane]; }
        const float* wp = a.ada_w + (size_t)(kc * 128) * 6144 + col;
#pragma unroll 8
        for (int k = 0; k < 64; ++k) { const f32x4 w = __builtin_nontemporal_load((const f32x4*)(wp + (size_t)k * 6144));
#pragma unroll
            for (int b = 0; b < 4; ++b) acc[b] += w * __builtin_bit_cast(float, __builtin_amdgcn_readlane(__builtin_bit_cast(int, c0[b]), k)); }
#pragma unroll 8
        for (int k = 0; k < 64; ++k) { const f32x4 w = __builtin_nontemporal_load((const f32x4*)(wp + (size_t)(64 + k) * 6144));
#pragma unroll
            for (int b = 0; b < 4; ++b) acc[b] += w * __builtin_bit_cast(float, __builtin_amdgcn_readlane(__builtin_bit_cast(int, c1[b]), k)); }
        float* mp = (float*)(ws + WS_MODP) + (size_t)kc * 4 * 6144 + col;
#pragma unroll
        for (int b = 0; b < 4; ++b) *(f32x4*)(mp + b * 6144) = acc[b];
    }
    LAS float* scr = (LAS float*)(lds + wave * 16384);
    constexpr int I_IN = 32 * (NPAD / 32), I_UP = 16 * 64, I_O = 32 * 64, NITEMS = I_IN + 2 * I_UP + I_O;
    for (int it = (wave - 2) * (int)gridDim.x + (int)blockIdx.x; wave >= 2 && it < NITEMS; it += 6 * (int)gridDim.x) {
        int r = it;
        if (r < I_IN) { const int nblk = NPAD / 32, kb = r / nblk, nb = r % nblk, n0 = nb * 32; const bool z = n0 >= IN_COLS;
            p0_transpose_item(a.w_in, IN_COLS, z ? 0 : win_src_col(n0), kb * 64, (bf16*)(ws + WS_WIN), 2048, n0, z, scr, lane); continue; }
        r -= I_IN;
        if (r < I_UP) { const int kb = r / 64, nb = r % 64; p0_transpose_item(a.w_up_r, 2048, nb * 32, kb * 64, (bf16*)(ws + WS_WUPR), 1024, nb * 32, false, scr, lane); continue; }
        r -= I_UP;
        if (r < I_UP) { const int kb = r / 64, nb = r % 64; p0_transpose_item(a.w_up_a, 2048, nb * 32, kb * 64, (bf16*)(ws + WS_WUPA), 1024, nb * 32, false, scr, lane); continue; }
        r -= I_UP;
        { const int kb = r / 64, nb = r % 64; p0_transpose_item(a.w_o, 2048, nb * 32, kb * 64, (bf16*)(ws + WS_WO), 2048, nb * 32, false, scr, lane); }
    }
    bf16* wl = (bf16*)(ws + WS_WLORA);
    for (int idx = blockIdx.x * NTHR + tid; idx < 2048 * 128; idx += gridDim.x * NTHR) {
        const int n = idx >> 7, k = idx & 127; float v = 0.f;
        if (n < 1024) { if (k < 64) v = a.w2[k * 1024 + n]; } else { if (k >= 64) v = a.a2[(k - 64) * 1024 + (n - 1024)]; }
        wl[idx] = (bf16)f2bf(v);
    }
}

__device__ __forceinline__ void p1_phase(const Args& a, LAS unsigned char* lds, int tid, int lane, int wave) {
    unsigned char* ws = a.ws;
    LAS float* mul = (LAS float*)lds; LAS float* add = mul + 2048;
    const float* modp = (const float*)(ws + WS_MODP);
    if (blockIdx.x < 4) {
        const int b = blockIdx.x, col = tid * 4; f32x4 s = *(const f32x4*)(a.ada_b + 4096 + col);
        for (int kc = 0; kc < 16; ++kc) s += *(const f32x4*)(modp + ((size_t)kc * 4 + b) * 6144 + 4096 + col);
        *(f32x4*)((float*)(ws + WS_GATEF) + b * 2048 + col) = s;
    }
    for (int rb = blockIdx.x; rb < M / 64; rb += gridDim.x) {
        const int b = rb / 64;
        __syncthreads();
        { const int col = tid * 4; f32x4 sh = *(const f32x4*)(a.ada_b + col), sc = *(const f32x4*)(a.ada_b + 2048 + col);
            for (int kc = 0; kc < 16; ++kc) { const float* p = modp + ((size_t)kc * 4 + b) * 6144; sh += *(const f32x4*)(p + col); sc += *(const f32x4*)(p + 2048 + col); }
            const f32x4 g = *(const f32x4*)(a.norm_g + col);
#pragma unroll
            for (int e = 0; e < 4; ++e) { mul[col + e] = g[e] * (1.0f + sc[e]); add[col + e] = sh[e]; } }
        __syncthreads();
        for (int i = 0; i < 8; ++i) {
            const int m = rb * 64 + wave * 8 + i;
            const f32x4* xr = (const f32x4*)(a.x + (size_t)m * D) + lane;
            f32x4 v[8]; float s = 0.f;
#pragma unroll
            for (int j = 0; j < 8; ++j) { v[j] = __builtin_nontemporal_load(xr + 64 * j); s += (v[j].x * v[j].x + v[j].y * v[j].y) + (v[j].z * v[j].z + v[j].w * v[j].w); }
            const float rstd = __builtin_amdgcn_rsqf(wave_sum(s) * (1.0f / D) + 1e-6f);
            unsigned long long* o8 = (unsigned long long*)((bf16*)(ws + WS_H) + (size_t)m * D) + lane;
#pragma unroll
            for (int j = 0; j < 8; ++j) { const int col = 4 * lane + 256 * j;
                const float h0 = v[j].x * rstd * mul[col] + add[col], h1 = v[j].y * rstd * mul[col + 1] + add[col + 1], h2 = v[j].z * rstd * mul[col + 2] + add[col + 2], h3 = v[j].w * rstd * mul[col + 3] + add[col + 3];
                o8[64 * j] = (unsigned long long)pk2(h0, h1) | ((unsigned long long)pk2(h2, h3) << 32); }
        }
    }
}

__device__ __forceinline__ void p3_phase(const Args& a, int lane, int wave) {
    unsigned char* ws = a.ws;
    const bf16* pwa = (const bf16*)(ws + WS_PWA);
    bf16* a2 = (bf16*)(ws + WS_A2);
    const int gw = blockIdx.x * NWAVES + wave, NGW = gridDim.x * NWAVES;
    const float muw0 = a.mu[4096 + 2 * lane], muw1 = a.mu[4096 + 2 * lane + 1];
    for (int m = gw; m < M; m += NGW) {
        const bool first = (m % SEQ) == 0;
        const unsigned wc = *(const unsigned*)(pwa + (size_t)m * 256 + 2 * lane);
        const unsigned wp = first ? 0u : *(const unsigned*)(pwa + (size_t)(m - 1) * 256 + 2 * lane);
        float v0 = bflo(wc), v1 = bfhi(wc);
        v0 += (bflo(wp) - v0) * muw0; v1 += (bfhi(wp) - v1) * muw1;
        if (lane < 32) { v0 = tanhf(v0); v1 = tanhf(v1); }
        *(unsigned*)(a2 + (size_t)m * 128 + 2 * lane) = pk2(v0, v1);
    }
}

namespace att {
constexpr int KP = 72, VP = 260, SP = 72;
constexpr int LDS_K = 0, LDS_V = 256 * KP * 2, LDS_S = LDS_V + 64 * VP * 2, LDS_TOTAL = LDS_S + 8 * 32 * SP * 2;
__device__ __forceinline__ int crow(int r, int hi) { return (r & 3) + 8 * (r >> 2) + 4 * hi; }
__device__ __forceinline__ void phase(const Args& a, LAS unsigned char* lds, int tid, int lane, int wave) {
    unsigned char* ws = a.ws;
    bf16* pat = (bf16*)(ws + WS_PAT);
    const int r32 = lane & 31, hi = lane >> 5;
    const int ch = tid & 7;
    float knw[8], qnw[8];
#pragma unroll
    for (int e = 0; e < 8; ++e) { knw[e] = a.k_norm[8 * ch + e]; qnw[e] = a.q_norm[8 * ch + e] * 0.125f; }
    LAS unsigned char* stg = lds + LDS_S + wave * (32 * SP * 2);
    for (int unit = blockIdx.x; unit < 512; unit += gridDim.x) {
        const int b = unit >> 7, kh = (unit >> 5) & 3, n = unit & 31;
        const int m0 = b * SEQ + n * 128;
        __syncthreads();
#pragma unroll
        for (int i = 0; i < 4; ++i) {
            const int s = (tid >> 3) + 64 * i; const bool valid = (n > 0) || (s >= 128);
            const bf16* src = pat + (size_t)(m0 - 128 + s) * 2560 + 2048 + kh * 64 + 8 * ch;
            float kf[8], vf[8];
            if (valid) { unpack8(__builtin_nontemporal_load((const u32x4*)src), kf); unpack8(__builtin_nontemporal_load((const u32x4*)(src + 256)), vf); }
            else {
#pragma unroll
                for (int e = 0; e < 8; ++e) { kf[e] = 0.f; vf[e] = 0.f; }
            }
            float ss = 0.f;
#pragma unroll
            for (int e = 0; e < 8; ++e) ss += kf[e] * kf[e];
            ss = oct8_sum(ss);
            const float rstd = __builtin_amdgcn_rsqf(ss * (1.0f / 64.0f) + 1e-6f);
            u32x4 w;
            w.x = pk2(kf[0] * rstd * knw[0], kf[1] * rstd * knw[1]); w.y = pk2(kf[2] * rstd * knw[2], kf[3] * rstd * knw[3]);
            w.z = pk2(kf[4] * rstd * knw[4], kf[5] * rstd * knw[5]); w.w = pk2(kf[6] * rstd * knw[6], kf[7] * rstd * knw[7]);
            *(LAS u32x4*)(lds + LDS_K + (s * KP + 8 * ch) * 2) = w;
            LAS bf16* vt = (LAS bf16*)(lds + LDS_V);
#pragma unroll
            for (int e = 0; e < 8; ++e) vt[(8 * ch + e) * VP + s] = (bf16)f2bf(vf[e]);
        }
        __syncthreads();
#pragma unroll 1
        for (int it = 0; it < 2; ++it) {
            const int task = wave + 8 * it, g = task >> 2, qq = task & 3, hq = kh * 4 + g;
            bf16* qbase = pat + (size_t)(m0 + 32 * qq) * 2560 + hq * 64;
#pragma unroll
            for (int i = 0; i < 4; ++i) { const int row = (lane >> 3) + 8 * i; float qv[8];
                unpack8(__builtin_nontemporal_load((const u32x4*)(qbase + (size_t)row * 2560 + 8 * ch)), qv);
                u32x4 w; w.x = pk2(qv[0] * qnw[0], qv[1] * qnw[1]); w.y = pk2(qv[2] * qnw[2], qv[3] * qnw[3]); w.z = pk2(qv[4] * qnw[4], qv[5] * qnw[5]); w.w = pk2(qv[6] * qnw[6], qv[7] * qnw[7]);
                float s2 = 0.f;
#pragma unroll
                for (int e = 0; e < 8; ++e) s2 += qv[e] * qv[e];
                s2 = oct8_sum(s2);
                *(LAS u32x4*)(stg + (row * SP + 8 * ch) * 2) = w;
                if (ch == 0) *(LAS float*)(stg + (row * SP + 64) * 2) = __builtin_amdgcn_rsqf(s2 * (1.0f / 64.0f) + 1e-6f);
            }
            asm volatile("s_waitcnt lgkmcnt(0)" ::: "memory");
            bf16x8 qb[4];
#pragma unroll
            for (int ks = 0; ks < 4; ++ks) qb[ks] = *(const LAS bf16x8*)(stg + (r32 * SP + 16 * ks + 8 * hi) * 2);
            const float qrs = *(const LAS float*)(stg + (r32 * SP + 64) * 2);
            f32x16 sc[5];
#pragma unroll
            for (int kt = 0; kt < 5; ++kt) {
#pragma unroll
                for (int r = 0; r < 16; ++r) sc[kt][r] = 0.f;
                const LAS unsigned char* kb = lds + LDS_K + ((32 * (qq + kt) + r32) * KP + 8 * hi) * 2;
#pragma unroll
                for (int ks = 0; ks < 4; ++ks) { const bf16x8 kfr = *(const LAS bf16x8*)(kb + 32 * ks);
                    sc[kt] = __builtin_amdgcn_mfma_f32_32x32x16_bf16(kfr, qb[ks], sc[kt], 0, 0, 0); }
            }
            const float sink = a.sinks[hq];
            float mx = sink;
#pragma unroll
            for (int kt = 0; kt < 5; ++kt)
#pragma unroll
                for (int r = 0; r < 16; ++r) { const int s = 32 * (qq + kt) + crow(r, hi); const int diff = 32 * qq + r32 + 128 - s;
                    const bool ok = (diff >= 0) && (diff < 128) && ((n > 0) || (s >= 128));
                    sc[kt][r] = ok ? sc[kt][r] * qrs : -1e30f; mx = fmaxf(mx, sc[kt][r]); }
            mx = fmaxf(mx, __shfl_xor(mx, 32));
            float l = 0.f;
#pragma unroll
            for (int kt = 0; kt < 5; ++kt)
#pragma unroll
                for (int r = 0; r < 16; ++r) { const float p = __expf(sc[kt][r] - mx); sc[kt][r] = p; l += p; }
            l += __shfl_xor(l, 32);
            l += __expf(sink - mx);
            f32x16 o[2];
#pragma unroll
            for (int dt = 0; dt < 2; ++dt)
#pragma unroll
                for (int r = 0; r < 16; ++r) o[dt][r] = 0.f;
#pragma unroll
            for (int kt = 0; kt < 5; ++kt)
#pragma unroll
                for (int s2 = 0; s2 < 2; ++s2) {
                    u32x4 pw; pw.x = pk2(sc[kt][8 * s2 + 0], sc[kt][8 * s2 + 1]); pw.y = pk2(sc[kt][8 * s2 + 2], sc[kt][8 * s2 + 3]);
                    pw.z = pk2(sc[kt][8 * s2 + 4], sc[kt][8 * s2 + 5]); pw.w = pk2(sc[kt][8 * s2 + 6], sc[kt][8 * s2 + 7]);
                    const bf16x8 pf = __builtin_bit_cast(bf16x8, pw);
                    const int keyb = 32 * (qq + kt) + 16 * s2 + 4 * hi;
#pragma unroll
                    for (int dt = 0; dt < 2; ++dt) {
                        const LAS unsigned char* vb = lds + LDS_V + ((32 * dt + r32) * VP + keyb) * 2;
                        const u32x2 lo = *(const LAS u32x2*)vb, hh = *(const LAS u32x2*)(vb + 16);
                        const u32x4 vv = (u32x4){lo.x, lo.y, hh.x, hh.y};
                        o[dt] = __builtin_amdgcn_mfma_f32_32x32x16_bf16(__builtin_bit_cast(bf16x8, vv), pf, o[dt], 0, 0, 0); }
                }
            const float rl = 1.0f / l;
#pragma unroll
            for (int dt = 0; dt < 2; ++dt)
#pragma unroll
                for (int g4 = 0; g4 < 4; ++g4) { const int d0 = 32 * dt + 8 * g4 + 4 * hi;
                    u32x2 w; w.x = pk2(o[dt][4 * g4 + 0] * rl, o[dt][4 * g4 + 1] * rl); w.y = pk2(o[dt][4 * g4 + 2] * rl, o[dt][4 * g4 + 3] * rl);
                    *(LAS u32x2*)(stg + (r32 * SP + d0) * 2) = w; }
            asm volatile("s_waitcnt lgkmcnt(0)" ::: "memory");
#pragma unroll
            for (int i = 0; i < 4; ++i) { const int row = (lane >> 3) + 8 * i; float ov[8], gv[8];
                bf16* rp = qbase + (size_t)row * 2560 + 8 * ch;
                unpack8(*(const LAS u32x4*)(stg + (row * SP + 8 * ch) * 2), ov); unpack8(__builtin_nontemporal_load((const u32x4*)(rp + 1024)), gv);
#pragma unroll
                for (int e = 0; e < 8; ++e) ov[e] = ov[e] * gv[e] * pg8::sigmoidf_(gv[e]);
                u32x4 w; w.x = pk2(ov[0], ov[1]); w.y = pk2(ov[2], ov[3]); w.z = pk2(ov[4], ov[5]); w.w = pk2(ov[6], ov[7]);
                *(u32x4*)rp = w; }
            asm volatile("s_waitcnt lgkmcnt(0)" ::: "memory");
        }
    }
    __syncthreads();
}
}

namespace scan {
constexpr int TT = 32, NT = SEQ / TT;
constexpr int OFF_R = 0, OFF_W = 2048, OFF_K = 4096, OFF_A = 6144, OFF_B = 8192, OFF_V = 10240, OFF_Y = 10752, BUF_F = 12800;
typedef float lf4 __attribute__((ext_vector_type(4)));
typedef float lf2 __attribute__((ext_vector_type(2)));

struct StageCtx { const bf16* prw; const _Float16 *aab, *wdb; float* bonus; bf16* yraw; int b, hh, quarter; float mur[4], muk[4], muv[4], ka[4], rk[4], kkw[4]; };
struct Raw { u32x2 r0, k0, v0, r1, k1, v1; h16x4 aa, wd; };
struct Ops { lf4 a, b, w, k, r; float v; };

__device__ __forceinline__ void stage_load(const StageCtx& c, int tau, int ht, Raw (&raw)[2]) {
#pragma unroll
    for (int i = 0; i < 2; ++i) {
        const int idx = ht + 256 * i, t = idx >> 4, c4 = (idx & 15) * 4, tt = tau * TT + t;
        const size_t m = (size_t)c.b * SEQ + tt; const int ch = c.hh * 64 + c4;
        const bf16* p = c.prw + m * 4096 + ch;
        raw[i].r0 = *(const u32x2*)p; raw[i].k0 = *(const u32x2*)(p + 1024); raw[i].v0 = *(const u32x2*)(p + 2048);
        const bf16* pp = (tt > 0) ? p - 4096 : p;
        raw[i].r1 = *(const u32x2*)pp; raw[i].k1 = *(const u32x2*)(pp + 1024); raw[i].v1 = *(const u32x2*)(pp + 2048);
        raw[i].aa = *(const h16x4*)(c.aab + m * 1024 + ch); raw[i].wd = *(const h16x4*)(c.wdb + m * 1024 + ch);
    }
}
__device__ __forceinline__ void stage_conv(const StageCtx& c, int tau, LAS float* buf, int ht, const Raw (&raw)[2]) {
#pragma unroll
    for (int i = 0; i < 2; ++i) {
        const int idx = ht + 256 * i, t = idx >> 4, c4 = (idx & 15) * 4, tt = tau * TT + t;
        const size_t m = (size_t)c.b * SEQ + tt;
        const float pz = (tt > 0) ? 1.0f : 0.0f;
        const u32x2 r0 = raw[i].r0, k0 = raw[i].k0, v0 = raw[i].v0, r1 = raw[i].r1, k1 = raw[i].k1, v1 = raw[i].v1;
        const float rc[4] = {bflo(r0.x), bfhi(r0.x), bflo(r0.y), bfhi(r0.y)}, rp[4] = {bflo(r1.x), bfhi(r1.x), bflo(r1.y), bfhi(r1.y)};
        const float kc[4] = {bflo(k0.x), bfhi(k0.x), bflo(k0.y), bfhi(k0.y)}, kp[4] = {bflo(k1.x), bfhi(k1.x), bflo(k1.y), bfhi(k1.y)};
        const float vc[4] = {bflo(v0.x), bfhi(v0.x), bflo(v0.y), bfhi(v0.y)}, vp[4] = {bflo(v1.x), bfhi(v1.x), bflo(v1.y), bfhi(v1.y)};
        lf4 R, W, K, A, Bv, V; float bon = 0.f, ks4[4], kk4[4], ss = 0.f;
#pragma unroll
        for (int e = 0; e < 4; ++e) { ks4[e] = kc[e] + (kp[e] * pz - kc[e]) * c.muk[e]; kk4[e] = ks4[e] * c.kkw[e]; ss += kk4[e] * kk4[e]; }
        ss = row16_sum(ss);
        const float kinv = __builtin_amdgcn_rsqf(fmaxf(ss, 1e-24f));
#pragma unroll
        for (int e = 0; e < 4; ++e) {
            const float rs = rc[e] + (rp[e] * pz - rc[e]) * c.mur[e], ks = ks4[e], vs = vc[e] + (vp[e] * pz - vc[e]) * c.muv[e];
            const float aa = (float)raw[i].aa[e], kk = kk4[e] * kinv;
            const float kn = ks * (1.0f + (aa - 1.0f) * c.ka[e]);
            R[e] = rs; W[e] = (float)raw[i].wd[e]; K[e] = kn; A[e] = -kk; Bv[e] = kk * aa; V[e] = vs; bon += rs * kn * c.rk[e];
        }
        *(LAS lf4*)(buf + OFF_R + t * 64 + c4) = R; *(LAS lf4*)(buf + OFF_W + t * 64 + c4) = W; *(LAS lf4*)(buf + OFF_K + t * 64 + c4) = K;
        *(LAS lf4*)(buf + OFF_A + t * 64 + c4) = A; *(LAS lf4*)(buf + OFF_B + t * 64 + c4) = Bv;
        if ((c4 >> 4) == c.quarter) *(LAS lf4*)(buf + OFF_V + t * 16 + (c4 & 15)) = V;
        bon = row16_sum(bon);
        if (c.quarter == 0 && (ht & 15) == 0) c.bonus[m * 16 + c.hh] = bon;
    }
}
__device__ __forceinline__ void write_y(const StageCtx& c, int tau, const LAS float* buf, int ht) {
    const int idx = ht * 2, t = idx >> 4, ii = idx & 15;
    const size_t m = (size_t)c.b * SEQ + tau * TT + t;
    const lf4 p0 = *(const LAS lf4*)(buf + OFF_Y + idx * 4), p1 = *(const LAS lf4*)(buf + OFF_Y + idx * 4 + 4);
    const float y0 = (p0.x + p0.y) + (p0.z + p0.w), y1 = (p1.x + p1.y) + (p1.z + p1.w);
    *(unsigned*)(c.yraw + m * 1024 + c.hh * 64 + c.quarter * 16 + ii) = pk2(y0, y1);
}

__device__ __forceinline__ void phase(const Args& a, LAS unsigned char* lds, int tid, int lane, int wave) {
    unsigned char* ws = a.ws;
    LAS float* bufs = (LAS float*)lds;
    for (int unit = blockIdx.x; unit < 256; unit += gridDim.x) {
        StageCtx c; c.prw = (const bf16*)(ws + WS_PRW); c.aab = (const _Float16*)(ws + WS_AA); c.wdb = (const _Float16*)(ws + WS_WDEC);
        c.bonus = (float*)(ws + WS_BONUS); c.yraw = (bf16*)(ws + WS_YRAW);
        const int bh = unit >> 2; c.quarter = unit & 3; c.b = bh >> 4; c.hh = bh & 15;
        const int ht = tid - 256;
        Raw raw[2];
        __syncthreads();
        if (wave >= 4) {
            const int ch = c.hh * 64 + (ht & 15) * 4;
#pragma unroll
            for (int e = 0; e < 4; ++e) { c.mur[e] = a.mu[ch + e]; c.muk[e] = a.mu[1024 + ch + e]; c.muv[e] = a.mu[2048 + ch + e]; c.ka[e] = a.k_a[ch + e]; c.rk[e] = a.r_k[ch + e]; c.kkw[e] = a.k_k[ch + e]; }
            stage_load(c, 0, ht, raw); stage_conv(c, 0, bufs, ht, raw); stage_load(c, 1, ht, raw);
        }
        __syncthreads();
        lf2 S01 = (lf2){0.f, 0.f}, S23 = (lf2){0.f, 0.f};
        const int rg = lane >> 4, cgp = lane & 15, rloc = (wave & 3) * 4 + rg;
#pragma unroll 1
        for (int tau = 0; tau < NT; ++tau) {
            LAS float* cur = bufs + (tau & 1) * BUF_F; LAS float* nxt = bufs + ((tau + 1) & 1) * BUF_F;
            if (wave < 4) {
                const LAS lf4* R4 = (const LAS lf4*)(cur + OFF_R) + cgp; const LAS lf4* W4 = (const LAS lf4*)(cur + OFF_W) + cgp; const LAS lf4* K4 = (const LAS lf4*)(cur + OFF_K) + cgp;
                const LAS lf4* A4 = (const LAS lf4*)(cur + OFF_A) + cgp; const LAS lf4* B4 = (const LAS lf4*)(cur + OFF_B) + cgp;
                const LAS float* Vp = cur + OFF_V + rloc; LAS float* Yp = cur + OFF_Y + rloc * 4 + (cgp & 3);
#define SC_LOAD(dst, g) do { _Pragma("unroll") for (int s_ = 0; s_ < GS; ++s_) { const int t_ = (g) * GS + s_; dst[s_].a = A4[t_ * 16]; dst[s_].b = B4[t_ * 16]; dst[s_].w = W4[t_ * 16]; \
                    dst[s_].k = K4[t_ * 16]; dst[s_].r = R4[t_ * 16]; dst[s_].v = Vp[t_ * 16]; } } while (0)
#define SC_STEPS(src, g) do { _Pragma("unroll") for (int s_ = 0; s_ < GS; ++s_) { const Ops& o_ = src[s_]; \
                    lf2 p = S01 * o_.a.xy; p = S23 * o_.a.zw + p; \
                    lf2 t01 = S01 * o_.w.xy; t01 = o_.k.xy * o_.v + t01; lf2 t23 = S23 * o_.w.zw; t23 = o_.k.zw * o_.v + t23; \
                    const float sa = row16_sum(p.x + p.y); \
                    S01 = o_.b.xy * sa + t01; S23 = o_.b.zw * sa + t23; \
                    lf2 q = S01 * o_.r.xy; q = S23 * o_.r.zw + q; \
                    float y = q.x + q.y; y += dpp_f<0x128>(y); y += dpp_f<0x124>(y); \
                    Yp[((g) * GS + s_) * 64] = y; } } while (0)
                constexpr int GS = 2; Ops oa[GS], ob[GS];
                SC_LOAD(oa, 0);
#pragma unroll 2
                for (int g = 0; g < TT / GS; g += 2) {
                    SC_LOAD(ob, g + 1);
                    SC_STEPS(oa, g);
                    const int g2 = (g + 2 < TT / GS) ? g + 2 : g;
                    SC_LOAD(oa, g2);
                    SC_STEPS(ob, g + 1);
                }
#undef SC_LOAD
#undef SC_STEPS
            } else {
                if (tau + 1 < NT) stage_conv(c, tau + 1, nxt, ht, raw);
                if (tau + 2 < NT) stage_load(c, tau + 2, ht, raw);
                if (tau >= 1) write_y(c, tau - 1, nxt, ht);
            }
            __syncthreads();
        }
        if (wave >= 4) write_y(c, NT - 1, bufs + ((NT - 1) & 1) * BUF_F, ht);
    }
    __syncthreads();
}
}

__device__ __forceinline__ void p6_phase(const Args& a, int lane, int wave) {
    unsigned char* ws = a.ws;
    bf16* prw = (bf16*)(ws + WS_PRW); const bf16* yraw = (const bf16*)(ws + WS_YRAW); const float* bonus = (const float*)(ws + WS_BONUS);
    const int gw = blockIdx.x * NWAVES + wave, NGW = gridDim.x * NWAVES;
    const int c0 = 16 * lane;
    float muv[16], mug[16], lw[16], lb[16];
#pragma unroll
    for (int e = 0; e < 16; ++e) { muv[e] = a.mu[2048 + c0 + e]; mug[e] = a.mu[3072 + c0 + e]; lw[e] = a.lnx_w[c0 + e]; lb[e] = a.lnx_b[c0 + e]; }
    for (int m0 = gw * 8; m0 < M; m0 += NGW * 8)
    for (int m = m0; m < m0 + 8; ++m) {
        const bool first = (m % SEQ) == 0;
        float y[16], vc[16], vp[16], gc[16], gp[16];
        const bf16* yp = yraw + (size_t)m * 1024 + c0;
        unpack8(__builtin_nontemporal_load((const u32x4*)yp), y); unpack8(__builtin_nontemporal_load((const u32x4*)(yp + 8)), y + 8);
        const bf16* pr = prw + (size_t)m * 4096 + c0;
        unpack8(*(const u32x4*)(pr + 2048), vc); unpack8(*(const u32x4*)(pr + 2048 + 8), vc + 8);
        unpack8(*(const u32x4*)(pr + 3072), gc); unpack8(*(const u32x4*)(pr + 3072 + 8), gc + 8);
        if (first) {
#pragma unroll
            for (int e = 0; e < 16; ++e) { vp[e] = 0.f; gp[e] = 0.f; }
        } else {
            unpack8(*(const u32x4*)(pr - 4096 + 2048), vp); unpack8(*(const u32x4*)(pr - 4096 + 2048 + 8), vp + 8);
            unpack8(*(const u32x4*)(pr - 4096 + 3072), gp); unpack8(*(const u32x4*)(pr - 4096 + 3072 + 8), gp + 8);
        }
        float s = 0.f;
#pragma unroll
        for (int e = 0; e < 16; ++e) s += y[e];
        s = quad4_sum(s);
        const float mean = s * (1.0f / 64.0f); float q = 0.f;
#pragma unroll
        for (int e = 0; e < 16; ++e) { y[e] -= mean; q += y[e] * y[e]; }
        q = quad4_sum(q);
        const float rstd = __builtin_amdgcn_rsqf(q * (1.0f / 64.0f) + 64e-5f);
        const float bon = bonus[(size_t)m * 16 + (lane >> 2)];
        float o[16];
#pragma unroll
        for (int e = 0; e < 16; ++e) {
            const float vs = vc[e] + (vp[e] - vc[e]) * muv[e], gs = gc[e] + (gp[e] - gc[e]) * mug[e];
            const float yn = y[e] * rstd * lw[e] + lb[e] + bon * vs;
            o[e] = yn * gs * pg8::sigmoidf_(gs);
        }
        u32x4 w0, w1;
        w0.x = pk2(o[0], o[1]); w0.y = pk2(o[2], o[3]); w0.z = pk2(o[4], o[5]); w0.w = pk2(o[6], o[7]);
        w1.x = pk2(o[8], o[9]); w1.y = pk2(o[10], o[11]); w1.z = pk2(o[12], o[13]); w1.w = pk2(o[14], o[15]);
        *(u32x4*)(prw + (size_t)m * 4096 + 1024 + c0) = w0; *(u32x4*)(prw + (size_t)m * 4096 + 1024 + c0 + 8) = w1;
    }
}


#define XB_TMO      128
#define XB_XCNT(j)  (256  + 64 * (j))
#define XB_XSUB(j)  (1280 + 64 * (j))
#define XB_XGEN(j)  (2304 + 64 * (j))
#define XB_TOP      3328
#define XB_TOPGEN   3392
#define XCD_BAR_WORDS 3456
#define XB_SPIN_CAP (1u << 22)
__device__ __forceinline__ unsigned xb_ld(unsigned* p)              { return __hip_atomic_load(p, __ATOMIC_RELAXED, __HIP_MEMORY_SCOPE_AGENT); }
__device__ __forceinline__ unsigned xb_add(unsigned* p, unsigned v) { return __hip_atomic_fetch_add(p, v, __ATOMIC_RELAXED, __HIP_MEMORY_SCOPE_AGENT); }
__device__ __forceinline__ unsigned xb_xcc_id() { return (unsigned)__builtin_amdgcn_s_getreg((3 << 11) | 20) & 0xFu; }
#define XB_SPIN(cond, bar) do { unsigned _sp = 0; while (cond) { __builtin_amdgcn_s_sleep(1); \
    if ((++_sp & 255u) == 0u) { if (xb_ld(&(bar)[XB_TMO])) break; if (_sp > XB_SPIN_CAP) { atomicAdd(&(bar)[XB_TMO], 1u); break; } } } } while (0)
struct XcdBarrier { unsigned* bar; unsigned x; volatile LAS unsigned* st; };
__device__ __forceinline__ XcdBarrier xcd_barrier_post(unsigned* bar, volatile LAS unsigned* st) {
    XcdBarrier b; b.bar = bar; b.x = xb_xcc_id(); b.st = st;
    if (threadIdx.x == 0) (void)xb_add(&bar[XB_XCNT(b.x)], 1u);
    return b;
}
__device__ __forceinline__ void xcd_barrier_complete(unsigned* bar, unsigned x, unsigned& nloc, unsigned& nx) {
    const unsigned G = gridDim.x * gridDim.y * gridDim.z;
    unsigned sum, cnt, mine, sp = 0u;
    for (;;) {
        sum = 0u; cnt = 0u; mine = 0u;
#pragma unroll
        for (unsigned j = 0; j < 16; ++j) { const unsigned c = xb_ld(&bar[XB_XCNT(j)]); sum += c; cnt += (c > 0u) ? 1u : 0u; mine = (j == x) ? c : mine; }
        if (sum == G) break;
        __builtin_amdgcn_s_sleep(1);
        if ((++sp & 255u) == 0u) { if (xb_ld(&bar[XB_TMO])) break; if (sp > XB_SPIN_CAP) { atomicAdd(&bar[XB_TMO], 1u); break; } }
    }
    nloc = mine > 0u ? mine : 1u; nx = cnt > 0u ? cnt : 1u;
}
__device__ __forceinline__ void xcd_barrier(const XcdBarrier& b) {
    asm volatile("s_waitcnt vmcnt(0)" ::: "memory");
    __syncthreads();
    if (threadIdx.x == 0) {
        unsigned* bar = b.bar;
        __builtin_amdgcn_s_waitcnt(0);
        unsigned nloc = b.st[0], nx = b.st[1];
        if (nloc == 0u) { xcd_barrier_complete(bar, b.x, nloc, nx); b.st[0] = nloc; b.st[1] = nx; }
        const unsigned old = xb_add(&bar[XB_XSUB(b.x)], 1u);
        const unsigned gen = old / nloc;
        if (old + 1u == (gen + 1u) * nloc) {
            __builtin_amdgcn_fence(__ATOMIC_RELEASE, "agent");
            asm volatile("s_waitcnt vmcnt(0)" ::: "memory");
            const unsigned og = xb_add(&bar[XB_TOP], 1u);
            const unsigned tg = og / nx;
            if (og + 1u == (tg + 1u) * nx) xb_add(&bar[XB_TOPGEN], 1u);
            else XB_SPIN(xb_ld(&bar[XB_TOPGEN]) == tg, bar);
            __builtin_amdgcn_fence(__ATOMIC_ACQUIRE, "agent");
            xb_add(&bar[XB_XGEN(b.x)], 1u);
            asm volatile("s_waitcnt vmcnt(0)" ::: "memory");
        } else {
            XB_SPIN(xb_ld(&bar[XB_XGEN(b.x)]) == gen, bar);
            __builtin_amdgcn_fence(__ATOMIC_ACQUIRE, "agent");
            asm volatile("s_waitcnt vmcnt(0)" ::: "memory");
        }
    }
    __syncthreads();
}

constexpr int N_PHASES = 9;
__device__ __forceinline__ const Args* fresh_args() {
    auto p = __builtin_amdgcn_kernarg_segment_ptr(); asm volatile("" : "+s"(p)); return (const Args*)p;
}
__global__ void __launch_bounds__(NTHR, 2) fwd_kernel(Args a_in) {
    extern __shared__ __attribute__((aligned(16))) unsigned char lds_raw[];
    LAS unsigned char* lds = (LAS unsigned char*)lds_raw;
    const int tid = threadIdx.x, lane = tid & 63, wave = __builtin_amdgcn_readfirstlane(tid >> 6);
    const int G = gridDim.x;
    const int lo = a_in.ph_lo, hi = a_in.ph_hi, rep_mask = a_in.rep_mask;
#ifndef PH_MASK
#define PH_MASK 0x1ff
#endif
#define IN(k) (((PH_MASK >> (k)) & 1) && lo <= (k) && (k) < hi)
#define REP(k) for (int rep_ = 0; rep_ < 1 + ((rep_mask >> (k)) & 1); ++rep_)
#define SEAM(k) do { if (IN(k) && IN((k) + 1)) { xcd_barrier(xbar); } } while (0)
    volatile LAS unsigned* misc = (volatile LAS unsigned*)(lds + LDS_MISC);
    if (tid < 2) misc[tid] = 0u;
    __syncthreads();
    XcdBarrier xbar; xbar.bar = (unsigned*)(a_in.ws + WS_BAR); xbar.x = 0; xbar.st = misc;
    if (hi - lo > 1) xbar = xcd_barrier_post((unsigned*)(a_in.ws + WS_BAR), misc);
    if (hi > N_PHASES) cg::this_grid().sync();
    if (IN(0)) REP(0) { const Args a = *fresh_args(); unsigned char* ws = a.ws; (void)ws; p0_phase(a, lds, tid, lane, wave); }
    SEAM(0);
    if (IN(1)) REP(1) { const Args a = *fresh_args(); unsigned char* ws = a.ws; (void)ws; p1_phase(a, lds, tid, lane, wave); __syncthreads(); }
    SEAM(1);
    if (IN(2)) REP(2) { const Args a = *fresh_args(); unsigned char* ws = a.ws; (void)ws;
        pg8::Gemm g{(const bf16*)(ws + WS_H), (const bf16*)(ws + WS_WIN), M, NPAD, D, D}; pg8::StaticOrder S; S.init(M, NPAD, G, (int)blockIdx.x);
        pg8::EpiIn E{(bf16*)(ws + WS_PRW), (bf16*)(ws + WS_PAT), (bf16*)(ws + WS_PG), (bf16*)(ws + WS_PWA)};
        pg8::gemm_phase<pg8::EpiIn, pg8::StaticOrder, true>(lds, g, S, E);
    }
    SEAM(2);
    if (IN(3)) REP(3) { const Args a = *fresh_args(); unsigned char* ws = a.ws; (void)ws; p3_phase(a, lane, wave); }
    SEAM(3);
    if (IN(4)) { const Args a = *fresh_args(); unsigned char* ws = a.ws; (void)ws;
        int kl = 128; asm volatile("" : "+s"(kl));
        pg8::Gemm g{(const bf16*)(ws + WS_A2), (const bf16*)(ws + WS_WLORA), M, 2048, kl, 128}; pg8::StaticOrder S; S.init(M, 2048, G, (int)blockIdx.x);
        pg8::EpiLora E{(_Float16*)(ws + WS_WDEC), (_Float16*)(ws + WS_AA), a.w0, a.a0};
        const bool att_first = ((blockIdx.x >> 3) & 1) != 0;
        if (att_first) att::phase(a, lds, tid, lane, wave);
        __syncthreads();
        pg8::gemm_phase<pg8::EpiLora, pg8::StaticOrder, true>(lds, g, S, E);
        __syncthreads();
        if (!att_first) att::phase(a, lds, tid, lane, wave);
    }
    SEAM(4);
    if (IN(5)) REP(5) { const Args a = *fresh_args(); unsigned char* ws = a.ws; (void)ws; scan::phase(a, lds, tid, lane, wave); }
    SEAM(5);
    if (IN(6)) REP(6) { const Args a = *fresh_args(); unsigned char* ws = a.ws; (void)ws;
        const bool rows_first = ((blockIdx.x >> 3) & 1) == 0;
        if (rows_first) p6_phase(a, lane, wave);
        __syncthreads();
        pg8::Gemm g{(const bf16*)(ws + WS_PAT), (const bf16*)(ws + WS_WUPA), M, 2048, 1024, 2560}; pg8::StaticOrder S; S.init(M, 2048, G, (int)blockIdx.x);
        pg8::EpiUp<false> E{(bf16*)(ws + WS_MB), (const bf16*)(ws + WS_PG), 2048};
        pg8::gemm_phase<pg8::EpiUp<false>, pg8::StaticOrder, true>(lds, g, S, E);
        __syncthreads();
        if (!rows_first) p6_phase(a, lane, wave);
    }
    SEAM(6);
    if (IN(7)) { const Args a = *fresh_args(); unsigned char* ws = a.ws; (void)ws;
        pg8::Gemm g{(const bf16*)(ws + WS_PRW) + 1024, (const bf16*)(ws + WS_WUPR), M, 2048, 1024, 4096}; pg8::StaticOrder S; S.init(M, 2048, G, (int)blockIdx.x);
        pg8::EpiUp<true> E{(bf16*)(ws + WS_MB), (const bf16*)(ws + WS_PG), 0};
        pg8::gemm_phase<pg8::EpiUp<true>, pg8::StaticOrder, true>(lds, g, S, E);
    }
    SEAM(7);
    if (IN(8)) REP(8) { const Args a = *fresh_args(); unsigned char* ws = a.ws; (void)ws;
        pg8::Gemm g{(const bf16*)(ws + WS_MB), (const bf16*)(ws + WS_WO), M, 2048, 2048, 2048}; pg8::StaticOrder S; S.init(M, 2048, G, (int)blockIdx.x);
        pg8::EpiOut E{a.x, a.out, (const float*)(ws + WS_GATEF)};
        pg8::gemm_phase<pg8::EpiOut, pg8::StaticOrder, true>(lds, g, S, E);
    }
#undef IN
#undef SEAM
}

extern "C" void kernel_launch(void* const* d_in, const int* in_sizes, int n_in, void* d_out, int out_size, void* d_ws, size_t ws_size, hipStream_t stream) {
    static int grid = 0;
    if (grid == 0) {
        if (n_in != 22 || in_sizes[0] != M * D || out_size != M * D || ws_size < WS_END) { fprintf(stderr, "kernel_launch: unexpected shapes (n_in %d, in0 %d, out %d, ws %zu); nothing launched\n", n_in, n_in > 0 ? in_sizes[0] : -1, out_size, ws_size); grid = -1; return; }
        int dev = 0, cus = 0, per_cu = 0;
        if (hipGetDevice(&dev) != hipSuccess || hipDeviceGetAttribute(&cus, hipDeviceAttributeMultiprocessorCount, dev) != hipSuccess) { grid = -1; return; }
        if (hipFuncSetAttribute((const void*)fwd_kernel, hipFuncAttributeMaxDynamicSharedMemorySize, LDS_BYTES) != hipSuccess) { fprintf(stderr, "kernel_launch: hipFuncSetAttribute failed\n"); grid = -1; return; }
        if (hipOccupancyMaxActiveBlocksPerMultiprocessor(&per_cu, (const void*)fwd_kernel, NTHR, LDS_BYTES) != hipSuccess || per_cu < 1) { fprintf(stderr, "kernel_launch: occupancy query failed (%d)\n", per_cu); (void)hipGetLastError(); per_cu = 1; }
        grid = cus * 1;
        if (grid > cus * per_cu) grid = cus * per_cu;
    }
    if (grid < 0) return;
    Args a{};
    const float** ap = (const float**)&a;
    for (int i = 0; i < 22; ++i) ap[i] = (const float*)d_in[i];
    a.out = (float*)d_out; a.ws = (unsigned char*)d_ws; a.rep_mask = REP_MASK;
#if MK_SPLIT
    for (int p = 0; p < N_PHASES; ++p) { a.ph_lo = p; a.ph_hi = p + 1; hipLaunchKernelGGL(fwd_kernel, dim3(grid), dim3(NTHR), LDS_BYTES, stream, a); }
#else
    a.ph_lo = 0; a.ph_hi = N_PHASES;
    if (hipMemsetAsync((char*)d_ws + WS_BAR, 0, 16384, stream) != hipSuccess) { fprintf(stderr, "kernel_launch: memset of the barrier words failed\n"); return; }
    void* args[] = {&a};
    hipError_t e = hipLaunchCooperativeKernel((const void*)fwd_kernel, dim3(grid), dim3(NTHR), args, LDS_BYTES, stream);
    if (e != hipSuccess) fprintf(stderr, "cooperative launch failed: %s (grid %d)\n", hipGetErrorString(e), grid);
#endif
}
```
